# Optimizing an MI355X kernel written in HIP

```python
import jax, jax.numpy as jnp
from jax import lax
import numpy as np

D_MODEL = 1024
BATCH = 2
SEQ = 16384
DEPTH = 2

HEAD_DIM = 64
ATTN_GROUPS = ((128, 1), (512, 4), (2048, 16))
N_ATTN_GROUPS = 3
HEADS_PER_GROUP = 8
ATTN_WIDTH = N_ATTN_GROUPS * HEADS_PER_GROUP * HEAD_DIM
ATTN_OUT = HEADS_PER_GROUP * HEAD_DIM
BLK = 128
REL_BUCKETS = 32
REL_MAX_DIST = 2048
NEG_INF = -1e30
SSM_CH = 16
SSM_WIDTH = D_MODEL // 2
SSM_GROUPS = SSM_WIDTH // SSM_CH
SSM_STATE = 64
PROJ_WIDTH = 3 * ATTN_WIDTH + SSM_WIDTH + 2 * D_MODEL
D_FF = 11 * D_MODEL // 4
N_EXPERTS = 8
TOP_K = 2
D_FF_EXPERT = 7 * D_MODEL // 2
MOE_BLOCK = 512
N_DENSE = (DEPTH + 1) // 2
N_MOE = DEPTH // 2
EPS = 1e-6

kernel_name = "hybrid_dilated_attn_s5_moe_trunk"


def rmsnorm(x, g):
    x32 = x.astype(jnp.float32)
    y = x32 * lax.rsqrt(jnp.mean(x32 * x32, axis=-1, keepdims=True) + EPS)
    return (y * g.astype(jnp.float32)).astype(x.dtype)


def _t5_bucket(dist):
    max_exact = REL_BUCKETS // 2
    d = np.maximum(dist, 1).astype(np.float64)
    large = max_exact + (np.log(d / max_exact) / np.log(REL_MAX_DIST / max_exact)
                         * (REL_BUCKETS - max_exact)).astype(np.int32)
    large = np.minimum(large, REL_BUCKETS - 1)
    return np.where(dist < max_exact, dist, large).astype(np.int32)


def _dilated_group(q, k, v, table, window, dilation):
    B, S, H, Dh = q.shape
    r = dilation
    steps = window // dilation
    L = S // r
    nb = -(-L // BLK)
    Lp = nb * BLK

    def to_blocks(t):
        t = t.reshape(B, L, r, H, Dh).transpose(0, 2, 1, 3, 4)
        t = jnp.pad(t, ((0, 0), (0, 0), (0, Lp - L), (0, 0), (0, 0)))
        return t.reshape(B, r, nb, BLK, H, Dh)

    qb, kb, vb = to_blocks(q), to_blocks(k), to_blocks(v)

    def with_prev(t):
        prev = jnp.pad(t[:, :, :-1], ((0, 0), (0, 0), (1, 0), (0, 0), (0, 0), (0, 0)))
        return jnp.concatenate([prev, t], axis=3)

    kw, vw = with_prev(kb), with_prev(vb)

    qi = np.arange(BLK)[:, None]
    kj = np.arange(2 * BLK)[None, :]
    delta = BLK + qi - kj
    band = (delta >= 0) & (delta <= steps)
    first = (np.arange(nb) == 0)[:, None, None] & (kj < BLK)[None]
    valid = band[None] & ~first
    bucket = _t5_bucket(np.clip(delta, 0, steps) * r)
    bias = jnp.transpose(table[bucket], (2, 0, 1)).astype(jnp.float32)

    logits = jnp.einsum('bcnqhd,bcnkhd->bcnhqk', qb, kw).astype(jnp.float32) * (HEAD_DIM ** -0.5) + bias
    logits = jnp.where(valid[None, None, :, None], logits, NEG_INF)
    m = jnp.max(logits, axis=-1, keepdims=True)
    p = jnp.exp(logits - m)
    s = jnp.sum(p, axis=-1, keepdims=True)
    o = jnp.einsum('bcnhqk,bcnkhd->bcnqhd', (p / s).astype(v.dtype), vw)
    lse = (m + jnp.log(s))[..., 0]

    o = o.reshape(B, r, Lp, H, Dh)[:, :, :L].transpose(0, 2, 1, 3, 4).reshape(B, S, H, Dh)
    lse = lse.transpose(0, 1, 2, 4, 3).reshape(B, r, Lp, H)[:, :, :L].transpose(0, 2, 1, 3).reshape(B, S, H)
    return o, lse


def dilated_mixture(q, k, v, rel_bias):
    B, S, _ = q.shape
    shp = (B, S, N_ATTN_GROUPS, HEADS_PER_GROUP, HEAD_DIM)
    q, k, v = q.reshape(shp), k.reshape(shp), v.reshape(shp)
    outs, lses = [], []
    for g, (window, dilation) in enumerate(ATTN_GROUPS):
        table = rel_bias[:, g * HEADS_PER_GROUP:(g + 1) * HEADS_PER_GROUP]
        o, l = _dilated_group(q[:, :, g], k[:, :, g], v[:, :, g], table, window, dilation)
        outs.append(o)
        lses.append(l)
    alpha = jax.nn.softmax(jnp.stack(lses), axis=0)
    o = jnp.einsum('gbsh,gbshd->bshd', alpha, jnp.stack(outs).astype(jnp.float32))
    return o.reshape(B, S, ATTN_OUT).astype(q.dtype)


def s5_layer(u, lam_re, lam_im, log_dt, b_re, b_im, c_re, c_im, d_skip, w_glu, b_glu):
    Bsz, S, _ = u.shape
    f32 = jnp.float32
    ug = u.astype(f32).reshape(Bsz, S, SSM_GROUPS, SSM_CH)
    lam = lax.complex(lam_re.astype(f32), lam_im.astype(f32))
    dt = jnp.exp(log_dt.astype(f32))[:, None]
    lam_bar = jnp.exp(lam * dt)
    b = lax.complex(b_re.astype(f32), b_im.astype(f32))
    c = lax.complex(c_re.astype(f32), c_im.astype(f32))
    b_bar = ((lam_bar - 1.0) / lam)[..., None] * b
    bu = jnp.einsum('gpc,bsgc->bsgp', b_bar, ug.astype(jnp.complex64))
    a = jnp.broadcast_to(lam_bar, bu.shape)

    def combine(e1, e2):
        a1, x1 = e1
        a2, x2 = e2
        return a2 * a1, a2 * x1 + x2

    _, states = lax.associative_scan(combine, (a, bu), axis=1)
    y = jnp.einsum('gcp,bsgp->bsgc', c, states).real.reshape(Bsz, S, SSM_WIDTH)
    y = y + d_skip.astype(f32) * u.astype(f32)
    z = jax.nn.gelu(y).astype(u.dtype)
    return z * jax.nn.sigmoid(z @ w_glu + b_glu)


def hybrid_mixer(h, rel_bias, w_in, lam_re, lam_im, log_dt, b_re, b_im, c_re, c_im,
                 d_skip, w_glu, b_glu, w_attn_br, w_ssm_br, w_out):
    proj = h @ w_in
    cuts = np.cumsum([ATTN_WIDTH, ATTN_WIDTH, ATTN_WIDTH, SSM_WIDTH, D_MODEL])
    q, k, v, u, g_attn, g_ssm = jnp.split(proj, cuts, axis=-1)
    y_attn = dilated_mixture(q, k, v, rel_bias) @ w_attn_br
    y_ssm = s5_layer(u, lam_re, lam_im, log_dt, b_re, b_im, c_re, c_im, d_skip, w_glu, b_glu) @ w_ssm_br
    merged = jax.nn.sigmoid(g_attn) * y_attn + jax.nn.sigmoid(g_ssm) * y_ssm
    return merged @ w_out


def swiglu(h, w_gate, w_up, w_down):
    return (jax.nn.silu(h @ w_gate) * (h @ w_up)) @ w_down


def moe_swiglu(h, w_router, w_gate, w_up, w_down):
    N, D = h.shape
    logits = (h @ w_router).astype(jnp.float32)
    top_val, top_idx = lax.top_k(logits, TOP_K)
    gates = jax.nn.softmax(top_val, axis=-1)
    A = N * TOP_K
    flat_e = top_idx.reshape(-1)
    flat_tok = jnp.arange(A, dtype=jnp.int32) // TOP_K
    flat_g = gates.reshape(-1)
    order = jnp.argsort(flat_e)
    sorted_e = flat_e[order]
    counts = jnp.bincount(flat_e, length=N_EXPERTS)
    padded = ((counts + MOE_BLOCK - 1) // MOE_BLOCK) * MOE_BLOCK
    pad_end = jnp.cumsum(padded)
    pad_start = pad_end - padded
    start = jnp.cumsum(counts) - counts
    slot = pad_start[sorted_e] + (jnp.arange(A) - start[sorted_e])
    n_blocks = -(-A // MOE_BLOCK) + N_EXPERTS
    n_slots = n_blocks * MOE_BLOCK
    slot_tok = jnp.full((n_slots,), N, jnp.int32).at[slot].set(flat_tok[order])
    slot_gate = jnp.zeros((n_slots,), jnp.float32).at[slot].set(flat_g[order])
    block_e = jnp.minimum(jnp.searchsorted(pad_end, jnp.arange(n_blocks) * MOE_BLOCK, side='right'),
                          N_EXPERTS - 1)
    h_pad = jnp.concatenate([h, jnp.zeros((1, D), h.dtype)], axis=0)
    xs = h_pad[slot_tok].reshape(n_blocks, MOE_BLOCK, D)

    def block_fn(args):
        xb, e = args
        return (jax.nn.silu(xb @ w_gate[e]) * (xb @ w_up[e])) @ w_down[e]

    ys = lax.map(block_fn, (xs, block_e)).reshape(n_slots, D)
    ys = ys.astype(jnp.float32) * slot_gate[:, None]
    out = jnp.zeros((N + 1, D), jnp.float32).at[slot_tok].add(ys)[:N]
    return out.astype(h.dtype)


def setup_inputs(seed: int = 0) -> dict:
    key = jax.random.key(seed)
    ks = iter(jax.random.split(key, 32))
    nrm = lambda shape, scale: jax.random.normal(next(ks), shape, jnp.float32) * scale
    G, P, Hc = SSM_GROUPS, SSM_STATE, SSM_CH
    n_idx = jnp.arange(P, dtype=jnp.float32)
    return {
        "x": nrm((BATCH, SEQ, D_MODEL), 1.0),
        "rel_bias": nrm((REL_BUCKETS, N_ATTN_GROUPS * HEADS_PER_GROUP), 0.1),
        "norm1_g": 1.0 + nrm((DEPTH, D_MODEL), 0.02),
        "w_in": nrm((DEPTH, D_MODEL, PROJ_WIDTH), D_MODEL ** -0.5),
        "ssm_lam_re": -0.5 + nrm((DEPTH, G, P), 0.01),
        "ssm_lam_im": jnp.pi * n_idx + nrm((DEPTH, G, P), 0.01),
        "ssm_log_dt": jax.random.uniform(next(ks), (DEPTH, G), jnp.float32,
                                         float(np.log(1e-3)), float(np.log(1e-1))),
        "ssm_b_re": nrm((DEPTH, G, P, Hc), (2 * Hc) ** -0.5),
        "ssm_b_im": nrm((DEPTH, G, P, Hc), (2 * Hc) ** -0.5),
        "ssm_c_re": nrm((DEPTH, G, Hc, P), (2 * P) ** -0.5),
        "ssm_c_im": nrm((DEPTH, G, Hc, P), (2 * P) ** -0.5),
        "ssm_d": nrm((DEPTH, SSM_WIDTH), 1.0),
        "w_glu": nrm((DEPTH, SSM_WIDTH, SSM_WIDTH), SSM_WIDTH ** -0.5),
        "b_glu": nrm((DEPTH, SSM_WIDTH), 0.01),
        "w_attn_br": nrm((DEPTH, ATTN_OUT, D_MODEL), ATTN_OUT ** -0.5),
        "w_ssm_br": nrm((DEPTH, SSM_WIDTH, D_MODEL), SSM_WIDTH ** -0.5),
        "w_out": nrm((DEPTH, D_MODEL, D_MODEL), D_MODEL ** -0.5),
        "norm2_g": 1.0 + nrm((DEPTH, D_MODEL), 0.02),
        "ffn_w_gate": nrm((N_DENSE, D_MODEL, D_FF), D_MODEL ** -0.5),
        "ffn_w_up": nrm((N_DENSE, D_MODEL, D_FF), D_MODEL ** -0.5),
        "ffn_w_down": nrm((N_DENSE, D_FF, D_MODEL), D_FF ** -0.5),
        "moe_router": nrm((N_MOE, D_MODEL, N_EXPERTS), D_MODEL ** -0.5),
        "moe_w_gate": nrm((N_MOE, N_EXPERTS, D_MODEL, D_FF_EXPERT), D_MODEL ** -0.5),
        "moe_w_up": nrm((N_MOE, N_EXPERTS, D_MODEL, D_FF_EXPERT), D_MODEL ** -0.5),
        "moe_w_down": nrm((N_MOE, N_EXPERTS, D_FF_EXPERT, D_MODEL), D_FF_EXPERT ** -0.5),
        "final_norm_g": 1.0 + nrm((D_MODEL,), 0.02),
    }


def reference(x, rel_bias, norm1_g, w_in, ssm_lam_re, ssm_lam_im, ssm_log_dt, ssm_b_re, ssm_b_im,
              ssm_c_re, ssm_c_im, ssm_d, w_glu, b_glu, w_attn_br, w_ssm_br, w_out, norm2_g,
              ffn_w_gate, ffn_w_up, ffn_w_down, moe_router, moe_w_gate, moe_w_up, moe_w_down,
              final_norm_g):
    B, S, D = x.shape
    for l in range(DEPTH):
        h = rmsnorm(x, norm1_g[l])
        x = x + hybrid_mixer(h, rel_bias, w_in[l], ssm_lam_re[l], ssm_lam_im[l], ssm_log_dt[l],
                             ssm_b_re[l], ssm_b_im[l], ssm_c_re[l], ssm_c_im[l], ssm_d[l],
                             w_glu[l], b_glu[l], w_attn_br[l], w_ssm_br[l], w_out[l])
        h = rmsnorm(x, norm2_g[l])
        if l % 2 == 0:
            i = l // 2
            x = x + swiglu(h, ffn_w_gate[i], ffn_w_up[i], ffn_w_down[i])
        else:
            i = l // 2
            x = x + moe_swiglu(h.reshape(B * S, D), moe_router[i], moe_w_gate[i], moe_w_up[i],
                               moe_w_down[i]).reshape(B, S, D)
    return rmsnorm(x, final_norm_g)
```

```cpp
#include <hip/hip_runtime.h>
#include <cstdio>
#include <cstdint>
namespace pg8 {
#define PG8_LAS __attribute__((address_space(3)))
typedef unsigned short bf16_t;
typedef short bf16x8 __attribute__((ext_vector_type(8)));
typedef float f32x4 __attribute__((ext_vector_type(4)));
typedef unsigned u32x4 __attribute__((ext_vector_type(4)));
constexpr int BM = 256, BK = 64, HALF = 128, HTB = HALF * BK * 2  , STAGE_BYTES = 8 * HTB, NXCD = 8, WGM = 8;

__host__ __device__ __forceinline__ int lds_byte(int r, int c) { const int st = (r >> 4) * 2 + (c >> 5), rr = r & 15, cc = c & 31, ob = rr * 64 + cc * 2; return st * 1024 + (ob ^ (((ob >> 9) & 1) << 5)); }
__host__ __device__ __forceinline__ void stage_rc(int b, int& R, int& C) { const int st = b / 1024, sb = b % 1024, swz = sb ^ (((sb >> 9) & 1) << 5); R = (st >> 1) * 16 + swz / 64; C = (st & 1) * 32 + (swz % 64) / 2; }
__host__ __device__ __forceinline__ int perm32(int rho) { const int n = rho >> 4, i = rho & 15; return 8 * (i >> 2) + 4 * n + (i & 3); }

struct Unit { int pm, pn; size_t boff; };
struct Gemm { const bf16_t* A; const bf16_t* Bt; int M, N, K; };

struct StaticOrder {
    int nM, nN, nwg, G, c;
    __host__ __device__ void init(int M, int N, int G_, int c_) { nM = M / BM; nN = N / BM; nwg = nM * nN; G = G_; c = c_; }
    __host__ __device__ bool next(int i, Unit& u) const {
        const long L = (long)i * G + c; if (L >= nwg) return false;
        int wgid = (int)L; { const int q = nwg / NXCD, r = nwg % NXCD, xcd = wgid % NXCD, off = wgid / NXCD; wgid = (xcd < r ? xcd * (q + 1) : r * (q + 1) + (xcd - r) * q) + off; }
        const int nig = WGM * nN, gid = wgid / nig, fm = gid * WGM, gsz = (nM - fm) < WGM ? (nM - fm) : WGM;
        u.pm = fm + ((wgid % nig) % gsz); u.pn = (wgid % nig) / gsz; u.boff = 0; return true;
    }
    __device__ __forceinline__ void a_ready(const Unit&) const {}
    __device__ __forceinline__ void done(const Unit&) const {}
};

typedef float f32x2c_t __attribute__((ext_vector_type(2))); typedef __bf16 bf16x2c_t __attribute__((ext_vector_type(2)));
__device__ __forceinline__ unsigned cvt_pk_bf16(float lo, float hi) { const f32x2c_t v = {lo, hi}; const bf16x2c_t b = __builtin_convertvector(v, bf16x2c_t); return __builtin_bit_cast(unsigned, b); }
typedef float f32x2 __attribute__((ext_vector_type(2)));
__device__ __forceinline__ f32x2 gelu_pk(f32x2 v) {
    const f32x2 av = __builtin_elementwise_abs(v), d = av * 0.2316418882f + 1.0f;
    f32x2 t; t.x = __builtin_amdgcn_rcpf(d.x); t.y = __builtin_amdgcn_rcpf(d.y);
    f32x2 q = t * 0.5307027145f + (-0.7265760135f); q = q * t + 0.7107068705f; q = q * t + (-0.142248368f); q = q * t + 0.127414796f; q = q * t;
    const f32x2 s = (v * v) * (-0.72134752044f);
    f32x2 e; e.x = __builtin_amdgcn_exp2f(s.x); e.y = __builtin_amdgcn_exp2f(s.y);
    const f32x2 m = v * (q * e), r = v - m;
    f32x2 o; o.x = v.x < 0.f ? m.x : r.x; o.y = v.y < 0.f ? m.y : r.y; return o;
}

template <int ACT  > struct EpiBf16 {
    static constexpr bool PERM = true, AFTER_DRAIN = false; static_assert(ACT == 0 || ACT == 1, "EpiBf16: ACT is 0 (none) or 1 (gelu_pk)");
    bf16_t* O; int ldc; const float* bias; int split_cols; size_t split_stride; float scale0;
    __device__ __forceinline__ void operator()(const f32x4 (&acc)[2][2][4][2], const Unit& u, int wr, int wc, int fr, int fq) const {
        const int row0 = u.pm * BM + wr * 64 + fr; int colt = u.pn * BM; bf16_t* base = O;
        float sc = 1.f; if (split_cols) { const int t = colt / split_cols; base += (size_t)t * split_stride; colt -= t * split_cols; if (t == 0) sc = scale0; }
        const int col0 = colt + wc * 32 + 8 * fq, bcol0 = u.pn * BM + wc * 32 + 8 * fq;
        f32x4 bv[2][2];
#pragma unroll
        for (int bj = 0; bj < 2; ++bj)
#pragma unroll
            for (int n = 0; n < 2; ++n) bv[bj][n] = bias ? *(const f32x4*)(bias + bcol0 + bj * HALF + 4 * n) : (f32x4){0.f, 0.f, 0.f, 0.f};
#pragma unroll
        for (int ai = 0; ai < 2; ++ai)
#pragma unroll
            for (int m = 0; m < 4; ++m) { bf16_t* rowp = base + (size_t)(row0 + ai * HALF + m * 16) * ldc + col0;
#pragma unroll
                for (int bj = 0; bj < 2; ++bj) { f32x4 v0 = acc[ai][bj][m][0] + bv[bj][0], v1 = acc[ai][bj][m][1] + bv[bj][1];
                    if (ACT == 1) { f32x2 a = gelu_pk((f32x2){v0[0], v0[1]}), b = gelu_pk((f32x2){v0[2], v0[3]}), c = gelu_pk((f32x2){v1[0], v1[1]}), d = gelu_pk((f32x2){v1[2], v1[3]});
                        v0 = (f32x4){a.x, a.y, b.x, b.y}; v1 = (f32x4){c.x, c.y, d.x, d.y}; }
                    v0 = v0 * sc; v1 = v1 * sc; u32x4 w; w.x = cvt_pk_bf16(v0[0], v0[1]); w.y = cvt_pk_bf16(v0[2], v0[3]); w.z = cvt_pk_bf16(v1[0], v1[1]); w.w = cvt_pk_bf16(v1[2], v1[3]);
                    *(u32x4*)(rowp + bj * HALF) = w; } }
    }
};

__device__ __forceinline__ float sigm(float x) { return __builtin_amdgcn_rcpf(1.0f + __builtin_amdgcn_exp2f(-1.4426950408889634f * x)); }
__device__ __forceinline__ float bflo(unsigned w) { return __uint_as_float(w << 16); }
__device__ __forceinline__ float bfhi(unsigned w) { return __uint_as_float(w & 0xffff0000u); }
__device__ __forceinline__ void st8(bf16_t* p, f32x4 v0, f32x4 v1) { u32x4 w; w.x = cvt_pk_bf16(v0[0], v0[1]); w.y = cvt_pk_bf16(v0[2], v0[3]); w.z = cvt_pk_bf16(v1[0], v1[1]); w.w = cvt_pk_bf16(v1[2], v1[3]); *(u32x4*)p = w; }
__device__ __forceinline__ void ld8(const bf16_t* p, f32x4& v0, f32x4& v1) { const u32x4 w = *(const u32x4*)p; v0 = (f32x4){bflo(w.x), bfhi(w.x), bflo(w.y), bfhi(w.y)}; v1 = (f32x4){bflo(w.z), bfhi(w.z), bflo(w.w), bfhi(w.w)}; }

struct EpiProj { static constexpr bool PERM = true, AFTER_DRAIN = false;
    bf16_t *Q, *Kp, *Vp, *U; float qscale;
    __device__ __forceinline__ void operator()(const f32x4 (&acc)[2][2][4][2], const Unit& u, int wr, int wc, int fr, int fq) const {
        const int row0 = u.pm * BM + wr * 64 + fr; const int pn = u.pn;
        bf16_t* base; int ldc, colt; float sc = 1.f;
        if (pn < 6) { base = Q; ldc = 1536; colt = pn * 256; sc = qscale; } else if (pn < 12) { base = Kp; ldc = 1536; colt = (pn - 6) * 256; }
        else if (pn < 18) { base = Vp; ldc = 1536; colt = (pn - 12) * 256; } else { base = U; ldc = 512; colt = (pn - 18) * 256; }
        const int col0 = colt + wc * 32 + 8 * fq;
#pragma unroll
        for (int ai = 0; ai < 2; ++ai)
#pragma unroll
            for (int m = 0; m < 4; ++m) { bf16_t* rowp = base + (size_t)(row0 + ai * HALF + m * 16) * ldc + col0;
#pragma unroll
                for (int bj = 0; bj < 2; ++bj) st8(rowp + bj * HALF, acc[ai][bj][m][0] * sc, acc[ai][bj][m][1] * sc); }
    }
};
struct EpiSig { static constexpr bool PERM = true, AFTER_DRAIN = false;
    bf16_t* O; int ldc;
    __device__ __forceinline__ void operator()(const f32x4 (&acc)[2][2][4][2], const Unit& u, int wr, int wc, int fr, int fq) const {
        const int row0 = u.pm * BM + wr * 64 + fr, col0 = u.pn * BM + wc * 32 + 8 * fq;
#pragma unroll
        for (int ai = 0; ai < 2; ++ai)
#pragma unroll
            for (int m = 0; m < 4; ++m) { bf16_t* rowp = O + (size_t)(row0 + ai * HALF + m * 16) * ldc + col0;
#pragma unroll
                for (int bj = 0; bj < 2; ++bj) { f32x4 v0 = acc[ai][bj][m][0], v1 = acc[ai][bj][m][1];
#pragma unroll
                    for (int k = 0; k < 4; ++k) { v0[k] = sigm(v0[k]); v1[k] = sigm(v1[k]); }
                    st8(rowp + bj * HALF, v0, v1); } }
    }
};
struct EpiPlain { static constexpr bool PERM = true, AFTER_DRAIN = false;
    bf16_t* O; int ldc;
    __device__ __forceinline__ void operator()(const f32x4 (&acc)[2][2][4][2], const Unit& u, int wr, int wc, int fr, int fq) const {
        const int row0 = u.pm * BM + wr * 64 + fr, col0 = u.pn * BM + wc * 32 + 8 * fq;
#pragma unroll
        for (int ai = 0; ai < 2; ++ai)
#pragma unroll
            for (int m = 0; m < 4; ++m) { bf16_t* rowp = O + (size_t)(row0 + ai * HALF + m * 16) * ldc + col0;
#pragma unroll
                for (int bj = 0; bj < 2; ++bj) st8(rowp + bj * HALF, acc[ai][bj][m][0], acc[ai][bj][m][1]); }
    }
};
struct EpiGlu { static constexpr bool PERM = true, AFTER_DRAIN = false;
    const bf16_t* Zin; bf16_t* O; int ldc; const float* bias;
    __device__ __forceinline__ void operator()(const f32x4 (&acc)[2][2][4][2], const Unit& u, int wr, int wc, int fr, int fq) const {
        const int row0 = u.pm * BM + wr * 64 + fr, col0 = u.pn * BM + wc * 32 + 8 * fq;
        f32x4 bv[2][2];
#pragma unroll
        for (int bj = 0; bj < 2; ++bj)
#pragma unroll
            for (int n = 0; n < 2; ++n) bv[bj][n] = *(const f32x4*)(bias + col0 + bj * HALF + 4 * n);
#pragma unroll
        for (int ai = 0; ai < 2; ++ai)
#pragma unroll
            for (int m = 0; m < 4; ++m) { const size_t off = (size_t)(row0 + ai * HALF + m * 16) * ldc + col0;
#pragma unroll
                for (int bj = 0; bj < 2; ++bj) { f32x4 z0, z1; ld8(Zin + off + bj * HALF, z0, z1);
                    f32x4 v0 = acc[ai][bj][m][0] + bv[bj][0], v1 = acc[ai][bj][m][1] + bv[bj][1];
#pragma unroll
                    for (int k = 0; k < 4; ++k) { v0[k] = z0[k] * sigm(v0[k]); v1[k] = z1[k] * sigm(v1[k]); }
                    st8(O + off + bj * HALF, v0, v1); } }
    }
};
template <int MODE> struct EpiGate { static constexpr bool PERM = true, AFTER_DRAIN = false;
    const bf16_t* G; int ldg, gcol0; bf16_t* O; int ldc;
    __device__ __forceinline__ void operator()(const f32x4 (&acc)[2][2][4][2], const Unit& u, int wr, int wc, int fr, int fq) const {
        const int row0 = u.pm * BM + wr * 64 + fr, col0 = u.pn * BM + wc * 32 + 8 * fq;
#pragma unroll
        for (int ai = 0; ai < 2; ++ai)
#pragma unroll
            for (int m = 0; m < 4; ++m) { const int row = row0 + ai * HALF + m * 16; const bf16_t* gp = G + (size_t)row * ldg + gcol0 + col0; bf16_t* op = O + (size_t)row * ldc + col0;
#pragma unroll
                for (int bj = 0; bj < 2; ++bj) { f32x4 g0, g1; ld8(gp + bj * HALF, g0, g1);
                    f32x4 v0 = acc[ai][bj][m][0] * g0, v1 = acc[ai][bj][m][1] * g1;
                    if (MODE == 1) { f32x4 p0, p1; ld8(op + bj * HALF, p0, p1); v0 = v0 + p0; v1 = v1 + p1; }
                    st8(op + bj * HALF, v0, v1); } }
    }
};
struct EpiResid { static constexpr bool PERM = false, AFTER_DRAIN = false;
    const float* base; float* out; int ldc;
    __device__ __forceinline__ void operator()(const f32x4 (&acc)[2][2][4][2], const Unit& u, int wr, int wc, int fr, int fq) const {
        const int row0 = u.pm * BM + wr * 64 + fr, col0 = u.pn * BM + wc * 32 + 4 * fq;
#pragma unroll
        for (int ai = 0; ai < 2; ++ai)
#pragma unroll
            for (int m = 0; m < 4; ++m) { const size_t off = (size_t)(row0 + ai * HALF + m * 16) * ldc + col0;
#pragma unroll
                for (int bj = 0; bj < 2; ++bj)
#pragma unroll
                    for (int n = 0; n < 2; ++n) { const f32x4 b = *(const f32x4*)(base + off + bj * HALF + n * 16); *(f32x4*)(out + off + bj * HALF + n * 16) = b + acc[ai][bj][m][n]; } }
    }
};
struct EpiSwiGlu { static constexpr bool PERM = true, AFTER_DRAIN = false;
    bf16_t* H; int ldc;
    __device__ __forceinline__ void operator()(const f32x4 (&acc)[2][2][4][2], const Unit& u, int wr, int wc, int fr, int fq) const {
        const int row0 = u.pm * BM + wr * 64 + fr, col0 = u.pn * HALF + wc * 32 + 8 * fq;
#pragma unroll
        for (int ai = 0; ai < 2; ++ai)
#pragma unroll
            for (int m = 0; m < 4; ++m) { f32x4 v0 = acc[ai][0][m][0], v1 = acc[ai][0][m][1]; const f32x4 u0 = acc[ai][1][m][0], u1 = acc[ai][1][m][1];
#pragma unroll
                for (int k = 0; k < 4; ++k) { v0[k] = v0[k] * sigm(v0[k]) * u0[k]; v1[k] = v1[k] * sigm(v1[k]) * u1[k]; }
                st8(H + (size_t)(row0 + ai * HALF + m * 16) * ldc + col0, v0, v1); }
    }
};
template <class Epi, class Sched, bool ALIGN_EPI = false, bool SP2 = false>
__device__ __forceinline__ void gemm_phase(PG8_LAS unsigned char* lds, const Gemm g, const Sched& S, const Epi& E) {
    int tid_ = threadIdx.x; asm volatile("" : "+v"(tid_));
    const int tid = tid_, wid = __builtin_amdgcn_readfirstlane(tid >> 6), lane = tid & 63, wr = wid >> 2, wc = wid & 3, fr = lane & 15, fq = lane >> 4;
    const int K = g.K, nt = K / BK;
    unsigned voffA[2], voffB[2];
#pragma unroll
    for (int i = 0; i < 2; ++i) { int R, C; stage_rc(tid * 16 + i * 8192, R, C); const int Rb = Epi::PERM ? ((R & ~31) + perm32(R & 31)) : R;
        voffA[i] = (unsigned)(R * K + C) * 2u; voffB[i] = (unsigned)(Rb * K + C) * 2u; }
    const size_t kstep = (size_t)(BK * 2);
    const size_t hstep = (size_t)HALF * K * 2;
    const size_t tstep = 2 * hstep;
    const unsigned ldsw = (unsigned)wid * 1024u;
    const int aoff = lds_byte(wr * 64 + fr, fq * 8), boff = lds_byte(wc * 32 + fr, fq * 8);
#define PG8_SA(b, h) (((b) * 2 + (h)) * HTB)
#define PG8_SB(b, h) ((4 + (b) * 2 + (h)) * HTB)
#define PG8_STAGE(bufoff, gbase, voff) do { _Pragma("unroll") for (int _i = 0; _i < 2; ++_i) \
        __builtin_amdgcn_global_load_lds((const unsigned*)((const char*)(gbase) + (voff)[_i]), (PG8_LAS unsigned*)(lds + (bufoff) + ldsw + _i * 8192), 16, 0, 0); } while (0)
#define PG8_LDA(dst, b, h) do { _Pragma("unroll") for (int m = 0; m < 4; ++m) _Pragma("unroll") for (int k = 0; k < 2; ++k) dst[m][k] = *(const PG8_LAS bf16x8*)(lds + PG8_SA(b, h) + aoff + m * 2048 + k * 1024); } while (0)
#define PG8_LDB(dst, b, h) do { _Pragma("unroll") for (int n = 0; n < 2; ++n) _Pragma("unroll") for (int k = 0; k < 2; ++k) dst[n][k] = *(const PG8_LAS bf16x8*)(lds + PG8_SB(b, h) + boff + n * 2048 + k * 1024); } while (0)
#define PG8_MMA(ai, bj, At, Bt) do { __builtin_amdgcn_s_setprio(1); _Pragma("unroll") for (int m = 0; m < 4; ++m) _Pragma("unroll") for (int n = 0; n < 2; ++n) _Pragma("unroll") for (int k = 0; k < 2; ++k) \
        acc[ai][bj][m][n] = __builtin_amdgcn_mfma_f32_16x16x32_bf16(Bt[n][k], At[m][k], acc[ai][bj][m][n], 0, 0, 0); __builtin_amdgcn_s_setprio(0); } while (0)
#define PG8_WAIT_V(n) asm volatile("s_waitcnt vmcnt(" #n ")" ::: "memory")
#define PG8_WAIT_L(n) asm volatile("s_waitcnt lgkmcnt(" #n ")" ::: "memory")
#define PG8_BAR __builtin_amdgcn_s_barrier()
#define PG8_SCHED __builtin_amdgcn_sched_barrier(0)
    Unit cur, nxt; int ui = 0;
    if (!S.next(0, cur)) return;
    f32x4 acc[2][2][4][2];
#pragma unroll
    for (int a = 0; a < 2; ++a)
#pragma unroll
        for (int b = 0; b < 2; ++b)
#pragma unroll
            for (int m = 0; m < 4; ++m)
#pragma unroll
                for (int n = 0; n < 2; ++n) acc[a][b][m][n] = (f32x4){0.f, 0.f, 0.f, 0.f};
    bf16x8 At[4][2], B0[2][2], B1[2][2];
    const char* cA = (const char*)g.A + (size_t)cur.pm * tstep; const char* cB = (const char*)g.Bt + cur.boff + (size_t)cur.pn * tstep;
    S.a_ready(cur);
    if constexpr (SP2) {
        PG8_STAGE(PG8_SB(0, 0), cB, voffB); PG8_STAGE(PG8_SB(0, 1), cB + hstep, voffB); PG8_STAGE(PG8_SA(0, 0), cA, voffA); PG8_STAGE(PG8_SA(0, 1), cA + hstep, voffA);
        if (wr == 1) PG8_BAR;
        PG8_WAIT_V(2); PG8_BAR;
        PG8_STAGE(PG8_SB(1, 0), cB + kstep, voffB); PG8_STAGE(PG8_SA(1, 0), cA + kstep, voffA); PG8_STAGE(PG8_SB(1, 1), cB + hstep + kstep, voffB);
        PG8_WAIT_V(6); PG8_BAR;
    } else {
        PG8_STAGE(PG8_SB(0, 0), cB, voffB); PG8_STAGE(PG8_SA(0, 0), cA, voffA); PG8_STAGE(PG8_SB(0, 1), cB + hstep, voffB); PG8_STAGE(PG8_SA(0, 1), cA + hstep, voffA);
        if (wr == 1) PG8_BAR;
        PG8_WAIT_V(4); PG8_BAR;
        PG8_STAGE(PG8_SB(1, 0), cB + kstep, voffB); PG8_STAGE(PG8_SA(1, 0), cA + kstep, voffA); PG8_STAGE(PG8_SB(1, 1), cB + hstep + kstep, voffB);
        PG8_WAIT_V(6); PG8_BAR;
    }
    for (;;) {
        const bool has_next = S.next(ui + 1, nxt);
        const char* nA = has_next ? (const char*)g.A + (size_t)nxt.pm * tstep : cA; const char* nB = has_next ? (const char*)g.Bt + nxt.boff + (size_t)nxt.pn * tstep : cB;
        for (int t = 0; t < nt; t += 2) {
            const bool last = (t == nt - 2);
            const char* a1 = cA + (size_t)(t + 1) * kstep;
            const char* a2 = last ? nA : cA + (size_t)(t + 2) * kstep; const char* b2 = last ? nB : cB + (size_t)(t + 2) * kstep;
            const char* a3 = a2 + kstep; const char* b3 = b2 + kstep;
            if (last && has_next) S.a_ready(nxt);
            if constexpr (SP2) {
            PG8_LDB(B0, 0, 0); PG8_LDB(B1, 0, 1); PG8_SCHED; PG8_LDA(At, 0, 0); PG8_STAGE(PG8_SA(1, 1), a1 + hstep, voffA);
            PG8_WAIT_V(8); PG8_WAIT_L(0); PG8_BAR; PG8_MMA(0, 0, At, B0); PG8_MMA(0, 1, At, B1); PG8_BAR; PG8_SCHED;
            PG8_LDA(At, 0, 1); PG8_STAGE(PG8_SB(0, 0), b2, voffB); PG8_STAGE(PG8_SB(0, 1), b2 + hstep, voffB); PG8_STAGE(PG8_SA(0, 0), a2, voffA);
            PG8_WAIT_V(8); PG8_WAIT_L(0); PG8_BAR; PG8_MMA(1, 0, At, B0); PG8_MMA(1, 1, At, B1); PG8_BAR; PG8_SCHED;
            PG8_LDB(B0, 1, 0); PG8_LDB(B1, 1, 1); PG8_SCHED; PG8_LDA(At, 1, 0); PG8_STAGE(PG8_SA(0, 1), a2 + hstep, voffA);
            PG8_WAIT_V(8); PG8_WAIT_L(0); PG8_BAR; PG8_MMA(0, 0, At, B0); PG8_MMA(0, 1, At, B1); PG8_BAR; PG8_SCHED;
            PG8_LDA(At, 1, 1); PG8_STAGE(PG8_SB(1, 0), b3, voffB); PG8_STAGE(PG8_SB(1, 1), b3 + hstep, voffB); PG8_STAGE(PG8_SA(1, 0), a3, voffA);
            PG8_WAIT_V(8); PG8_WAIT_L(0); PG8_BAR; PG8_MMA(1, 0, At, B0); PG8_MMA(1, 1, At, B1); PG8_BAR; PG8_SCHED;
            } else {
            PG8_LDB(B0, 0, 0); PG8_SCHED; PG8_LDA(At, 0, 0); PG8_STAGE(PG8_SA(1, 1), a1 + hstep, voffA);
            PG8_WAIT_L(8); PG8_BAR; PG8_WAIT_L(0); PG8_MMA(0, 0, At, B0); PG8_BAR; PG8_SCHED;
            PG8_LDB(B1, 0, 1); PG8_STAGE(PG8_SB(0, 0), b2, voffB);
            PG8_BAR; PG8_WAIT_L(0); PG8_MMA(0, 1, At, B1); PG8_BAR;
            PG8_LDA(At, 0, 1); PG8_STAGE(PG8_SA(0, 0), a2, voffA);
            PG8_BAR; PG8_WAIT_L(0); PG8_MMA(1, 0, At, B0); PG8_BAR; PG8_SCHED;
            PG8_STAGE(PG8_SB(0, 1), b2 + hstep, voffB);
            PG8_WAIT_V(6); PG8_BAR; PG8_MMA(1, 1, At, B1); PG8_BAR;
            PG8_LDB(B0, 1, 0); PG8_SCHED; PG8_LDA(At, 1, 0); PG8_STAGE(PG8_SA(0, 1), a2 + hstep, voffA);
            PG8_WAIT_L(8); PG8_BAR; PG8_WAIT_L(0); PG8_MMA(0, 0, At, B0); PG8_BAR; PG8_SCHED;
            PG8_LDB(B1, 1, 1); PG8_STAGE(PG8_SB(1, 0), b3, voffB);
            PG8_BAR; PG8_WAIT_L(0); PG8_MMA(0, 1, At, B1); PG8_BAR;
            PG8_LDA(At, 1, 1); PG8_STAGE(PG8_SA(1, 0), a3, voffA);
            PG8_BAR; PG8_WAIT_L(0); PG8_MMA(1, 0, At, B0); PG8_BAR; PG8_SCHED;
            PG8_STAGE(PG8_SB(1, 1), b3 + hstep, voffB);
            PG8_WAIT_V(6); PG8_BAR; PG8_MMA(1, 1, At, B1); PG8_BAR;
            }
        }
        if constexpr (ALIGN_EPI) { if (wr == 0) PG8_BAR; }
        if constexpr (!Epi::AFTER_DRAIN) { E(acc, cur, wr, wc, fr, fq); S.done(cur); }
        if (!has_next) break;
#pragma unroll
        for (int a = 0; a < 2; ++a)
#pragma unroll
            for (int b = 0; b < 2; ++b)
#pragma unroll
                for (int m = 0; m < 4; ++m)
#pragma unroll
                    for (int n = 0; n < 2; ++n) acc[a][b][m][n] = (f32x4){0.f, 0.f, 0.f, 0.f};
        cur = nxt; cA = nA; cB = nB; ++ui;
        if constexpr (ALIGN_EPI) { if (wr == 1) PG8_BAR; }
    }
    PG8_WAIT_V(0);
    if constexpr (!ALIGN_EPI) { if (wr == 0) PG8_BAR; }
    PG8_BAR;
    if constexpr (Epi::AFTER_DRAIN) { E.fused(acc, cur, wr, wc, fr, fq, lds, wid, lane); S.done(cur); }
#undef PG8_SA
#undef PG8_SB
#undef PG8_STAGE
#undef PG8_LDA
#undef PG8_LDB
#undef PG8_MMA
#undef PG8_WAIT_V
#undef PG8_WAIT_L
#undef PG8_BAR
#undef PG8_SCHED
}
}

#define GAS __attribute__((address_space(1)))
#define LAS __attribute__((address_space(3)))
typedef unsigned short bf16;
typedef unsigned v4u __attribute__((ext_vector_type(4)));
typedef float f32x4 __attribute__((ext_vector_type(4)));
typedef short bf16x8 __attribute__((ext_vector_type(8)));
typedef GAS unsigned gu32;
typedef GAS unsigned long long gu64;
#define RLX_AGENT __ATOMIC_RELAXED, __HIP_MEMORY_SCOPE_AGENT
#define LDS_WAIT() asm volatile("s_waitcnt lgkmcnt(0)" ::: "memory")
#define VM_WAIT() asm volatile("s_waitcnt vmcnt(0)" ::: "memory")
__device__ __forceinline__ unsigned long long rt() { return __builtin_amdgcn_s_memrealtime(); }
__device__ __forceinline__ unsigned f2bf(float f) { unsigned u = __builtin_bit_cast(unsigned, f); return (u + 0x7fffu + ((u >> 16) & 1u)) >> 16; }
__device__ __forceinline__ unsigned pk2(float lo, float hi) { return f2bf(lo) | (f2bf(hi) << 16); }

#define XB_TMO      128
#define XB_XCNT(j)  (256  + 64 * (j))
#define XB_XSUB(j)  (1280 + 64 * (j))
#define XB_XGEN(j)  (2304 + 64 * (j))
#define XB_TOP      3328
#define XB_TOPGEN   3392
#define XCD_BAR_WORDS 3456
#define XB_SPIN_CAP (1u << 18)

__device__ __forceinline__ unsigned xb_ld(unsigned* p)              { return __hip_atomic_load(p, __ATOMIC_RELAXED, __HIP_MEMORY_SCOPE_AGENT); }
__device__ __forceinline__ unsigned xb_add(unsigned* p, unsigned v) { return __hip_atomic_fetch_add(p, v, __ATOMIC_RELAXED, __HIP_MEMORY_SCOPE_AGENT); }
__device__ __forceinline__ unsigned xb_xcc_id() { return (unsigned)__builtin_amdgcn_s_getreg((3 << 11) | 20) & 0xFu; }
#define XB_SPIN(cond, bar) do { unsigned _sp = 0; while (cond) { __builtin_amdgcn_s_sleep(1); \
    if ((++_sp & 255u) == 0u) { if (xb_ld(&(bar)[XB_TMO])) break; if (_sp > XB_SPIN_CAP) { atomicAdd(&(bar)[XB_TMO], 1u); break; } } } } while (0)

struct XcdBarrier {
    unsigned* bar; unsigned x;
    volatile LAS unsigned* st;
};

__device__ __forceinline__ XcdBarrier xcd_barrier_post(unsigned* bar, volatile LAS unsigned* st) {
    XcdBarrier b; b.bar = bar; b.x = xb_xcc_id(); b.st = st;
    if (threadIdx.x == 0) (void)xb_add(&bar[XB_XCNT(b.x)], 1u);
    return b;
}
__device__ __forceinline__ void xcd_barrier_complete(unsigned* bar, unsigned x, unsigned& nloc, unsigned& nx) {
    const unsigned G = gridDim.x * gridDim.y * gridDim.z;
    unsigned sum, cnt, mine, sp = 0u;
    for (;;) {
        sum = 0u; cnt = 0u; mine = 0u;
#pragma unroll
        for (unsigned j = 0; j < 16; ++j) { const unsigned c = xb_ld(&bar[XB_XCNT(j)]); sum += c; cnt += (c > 0u) ? 1u : 0u; mine = (j == x) ? c : mine; }
        if (sum == G) break;
        __builtin_amdgcn_s_sleep(1);
        if ((++sp & 255u) == 0u) { if (xb_ld(&bar[XB_TMO])) break; if (sp > XB_SPIN_CAP) { atomicAdd(&bar[XB_TMO], 1u); break; } }
    }
    nloc = mine > 0u ? mine : 1u; nx = cnt > 0u ? cnt : 1u;
}

__device__ __forceinline__ void xcd_barrier(const XcdBarrier& b) {
    asm volatile("s_waitcnt vmcnt(0)" ::: "memory");
    __syncthreads();
    if (threadIdx.x == 0) {
        unsigned* bar = b.bar;
        __builtin_amdgcn_s_waitcnt(0);
        unsigned nloc = b.st[0], nx = b.st[1];
        if (nloc == 0u) { xcd_barrier_complete(bar, b.x, nloc, nx); b.st[0] = nloc; b.st[1] = nx; }
        const unsigned old = xb_add(&bar[XB_XSUB(b.x)], 1u);
        const unsigned gen = old / nloc;
        if (old + 1u == (gen + 1u) * nloc) {
            __builtin_amdgcn_fence(__ATOMIC_RELEASE, "agent");
            asm volatile("s_waitcnt vmcnt(0)" ::: "memory");
            const unsigned og = xb_add(&bar[XB_TOP], 1u);
            const unsigned tg = og / nx;
            if (og + 1u == (tg + 1u) * nx) xb_add(&bar[XB_TOPGEN], 1u);
            else XB_SPIN(xb_ld(&bar[XB_TOPGEN]) == tg, bar);
            __builtin_amdgcn_fence(__ATOMIC_ACQUIRE, "agent");
            xb_add(&bar[XB_XGEN(b.x)], 1u);
            asm volatile("s_waitcnt vmcnt(0)" ::: "memory");
        } else {
            XB_SPIN(xb_ld(&bar[XB_XGEN(b.x)]) == gen, bar);
            __builtin_amdgcn_fence(__ATOMIC_ACQUIRE, "agent");
            asm volatile("s_waitcnt vmcnt(0)" ::: "memory");
        }
    }
    __syncthreads();
}

constexpr int NWAVES = 8;
constexpr int DM = 1024, BATCH = 2, SEQ = 16384, NTOK = BATCH * SEQ;
constexpr int AW = 1536, AOUT = 512, SW = 512, PW = 7168, NQKVU = 5120, NGATE = 2048;
constexpr int FF = 2816, FFE = 3584, NEXP = 8;
constexpr int SSM_G = 32, SSM_P = 64, SSM_C = 16, CHUNK = 128, NCHUNK = SEQ / CHUNK;
constexpr float EPS = 1e-6f;
constexpr float LOG2E = 1.4426950408889634f;
constexpr int MOE_ROWS = 2 * NTOK + NEXP * 256;
constexpr int MOE_CHUNK_TILES = 64, MOE_NCHUNK = 5;
constexpr int N_PHASES = 26;

constexpr size_t MiB = 1u << 20, KiB = 1u << 10;
constexpr size_t WS_CTL = 0, CTL_ZERO_BYTES = 1 * MiB;
constexpr size_t TAB_BIAS = 1 * MiB;
constexpr size_t TAB_LAMB = 1 * MiB + 16 * KiB;
constexpr size_t TAB_BB   = 1 * MiB + 64 * KiB;
constexpr size_t TAB_CM   = 1 * MiB + 320 * KiB;
constexpr size_t TOK_E = 2 * MiB, TOK_R = TOK_E + 128 * KiB, TOK_G = TOK_R + 256 * KiB, TOK_S = TOK_G + 256 * KiB, CNTWG = TOK_S + 256 * KiB;
constexpr size_t WS_LSE = 4 * MiB;
constexpr size_t WS_E = 8 * MiB;
constexpr size_t WS_WS = 12 * MiB, WL_STRIDE = 18 * MiB + 512 * KiB;
constexpr size_t WL_QKVU = 0, WL_G = 10 * MiB, WL_GLU = 14 * MiB, WL_ABR = 14 * MiB + 512 * KiB, WL_SBR = 15 * MiB + 512 * KiB, WL_OUT = 16 * MiB + 512 * KiB;
constexpr size_t WS_W13 = WS_WS + 37 * MiB, WS_W2 = WS_WS + 48 * MiB;
constexpr size_t WS_H = 66 * MiB, WS_QP = 130 * MiB, WS_KP = 226 * MiB, WS_VP = 322 * MiB, WS_U = 418 * MiB, WS_Z = 450 * MiB, WS_AO = 482 * MiB;
constexpr size_t WS_G = WS_KP, WS_M = WS_QP, WS_ZG = WS_U, WS_HID = 130 * MiB;
constexpr size_t WS_MW13 = 12 * MiB, WS_MW2 = 124 * MiB, WS_XS = 180 * MiB, WS_HID0 = 312 * MiB, WS_HID1 = 424 * MiB, WS_END = 536 * MiB;
static_assert(WS_W2 + (size_t)DM * FF * 2 <= WS_H && WS_AO + (size_t)NTOK * AOUT * 2 <= WS_END && WS_HID + (size_t)NTOK * FF * 2 <= WS_U, "ws map");
static_assert(WS_MW13 + (size_t)NEXP * 2 * FFE * DM * 2 == WS_MW2 && WS_MW2 + (size_t)NEXP * DM * FFE * 2 == WS_XS && WS_XS + (size_t)MOE_ROWS * DM * 2 == WS_HID0 && WS_HID0 + (size_t)MOE_CHUNK_TILES * 256 * FFE * 2 == WS_HID1, "moe ws map");
constexpr int CW_TMO = 0, CW_BAR = 4096;

constexpr int RING_BYTES = 131072, LDSCTL_OFF = RING_BYTES, MISC_OFF = LDSCTL_OFF + 320, LDS_BYTES = 147456;

struct Ctx { LAS unsigned char* lds; int tid, lane, wave, vcu, G; };
typedef float f32x2v __attribute__((ext_vector_type(2)));
typedef int i32x2v __attribute__((ext_vector_type(2)));
typedef short v4i16_t __attribute__((ext_vector_type(4)));
__device__ __forceinline__ float wave_sum(float v) {
#pragma unroll
    for (int o = 1; o < 64; o <<= 1) v += __shfl_xor(v, o);
    return v;
}
__device__ __forceinline__ float bf2f(bf16 h) { return __uint_as_float((unsigned)h << 16); }
__device__ __forceinline__ float sigm_f(float x) { return __builtin_amdgcn_rcpf(1.0f + __builtin_amdgcn_exp2f(-LOG2E * x)); }
__device__ __forceinline__ unsigned cvtpk(float lo, float hi) { return pg8::cvt_pk_bf16(lo, hi); }

__device__ __forceinline__ void build_tables(const Ctx& C, const float* rel_bias, const float* lam_re, const float* lam_im, const float* log_dt,
                                             const float* b_re, const float* b_im, const float* c_re, const float* c_im, unsigned char* ws) {
    const int gt = C.vcu * 512 + C.tid, GT = C.G * 512;
    float* bt = (float*)(ws + TAB_BIAS);
    for (int i = gt; i < 3 * 8 * 129; i += GT) {
        const int g = i / (8 * 129), rem = i % (8 * 129), j = rem / 129, dl = rem % 129;
        const int r = (g == 0) ? 1 : (g == 1 ? 4 : 16), dist = dl * r; int bk;
        if (dist < 16) bk = dist; else { const int v = 16 + (int)(log((double)dist / 16.0) / log(128.0) * 16.0); bk = v < 31 ? v : 31; }
        bt[(g * 8 + j) * 132 + dl] = rel_bias[bk * 24 + g * 8 + j] * LOG2E;
    }
    f32x2v* lamb = (f32x2v*)(ws + TAB_LAMB); bf16* BB = (bf16*)(ws + TAB_BB); bf16* CM = (bf16*)(ws + TAB_CM);
    for (int i = gt; i < 2 * SSM_G * SSM_P; i += GT) {
        const int gi = i >> 6, p = i & 63;
        const double dt = exp((double)log_dt[gi]), lr = (double)lam_re[i], li = (double)lam_im[i];
        const double mag = exp(lr * dt), ang = li * dt, lbx = mag * cos(ang), lby = mag * sin(ang);
        const double nx = lbx - 1.0, ny = lby, den = lr * lr + li * li, qx = (nx * lr + ny * li) / den, qy = (ny * lr - nx * li) / den;
        lamb[i] = (f32x2v){(float)lbx, (float)lby};
        for (int c = 0; c < 16; ++c) { const double br = (double)b_re[(size_t)i * 16 + c], bi = (double)b_im[(size_t)i * 16 + c];
            BB[((size_t)gi * 128 + 2 * p) * 16 + c] = (bf16)f2bf((float)(qx * br - qy * bi)); BB[((size_t)gi * 128 + 2 * p + 1) * 16 + c] = (bf16)f2bf((float)(qx * bi + qy * br)); }
        for (int c = 0; c < 16; ++c) { CM[((size_t)gi * 16 + c) * 128 + 2 * p] = (bf16)f2bf(c_re[((size_t)gi * 16 + c) * 64 + p]); CM[((size_t)gi * 16 + c) * 128 + 2 * p + 1] = (bf16)f2bf(-c_im[((size_t)gi * 16 + c) * 64 + p]); }
    }
}
template <int MODE>
__device__ __forceinline__ void transpose_item(const float* W, int K, int ldw, int c0, int ncols, bf16* WT, int row0, LAS float* scr, int item, int lane) {
    const int nblk = ncols / 32, kb = item / nblk, nb = item % nblk, k0 = 64 * kb, n0 = 32 * nb;
#pragma unroll 8
    for (int i = 0; i < 32; ++i) { const int kk = 2 * i + (lane >> 5); scr[kk * 33 + (lane & 31)] = W[(size_t)(k0 + kk) * ldw + c0 + n0 + (lane & 31)]; }
    LDS_WAIT(); asm volatile("" ::: "memory");
    const int c = lane & 7;
#pragma unroll
    for (int j = 0; j < 4; ++j) { const int n = (lane >> 3) + 8 * j; const LAS float* s = scr + (8 * c) * 33 + n;
        v4u o; o.x = pk2(s[0 * 33], s[1 * 33]); o.y = pk2(s[2 * 33], s[3 * 33]); o.z = pk2(s[4 * 33], s[5 * 33]); o.w = pk2(s[6 * 33], s[7 * 33]);
        const int nn = n0 + n; const int drow = MODE ? row0 + (nn >> 7) * 256 + (nn & 127) : row0 + nn;
        *(GAS v4u*)(WT + (size_t)drow * K + k0 + 8 * c) = o; }
    LDS_WAIT(); asm volatile("" ::: "memory");
}
__device__ __forceinline__ void convert_small_weights(const Ctx& C, const float* const* in, unsigned char* ws) {
    LAS float* scr = (LAS float*)(C.lds + C.wave * 16384);
    const int gw = C.vcu * NWAVES + C.wave, NGW = C.G * NWAVES;
    constexpr int I1 = 16 * 160, I2 = 16 * 64, I3 = 8 * 16, I4 = 8 * 32, I5 = 8 * 32, I6 = 16 * 32, IL = I1 + I2 + I3 + I4 + I5 + I6;
    constexpr int I7 = 16 * 88, I8 = 16 * 88, I9 = 44 * 32, NITEMS = 2 * IL + I7 + I8 + I9;
    for (int it = gw; it < NITEMS; it += NGW) {
        int r = it;
        if (r < 2 * IL) { const int l = r / IL; r -= l * IL; unsigned char* wl = ws + WS_WS + (size_t)l * WL_STRIDE;
            if (r < I1) { transpose_item<0>(in[3] + (size_t)l * DM * PW, DM, PW, 0, NQKVU, (bf16*)(wl + WL_QKVU), 0, scr, r, C.lane); continue; } r -= I1;
            if (r < I2) { transpose_item<0>(in[3] + (size_t)l * DM * PW, DM, PW, NQKVU, NGATE, (bf16*)(wl + WL_G), 0, scr, r, C.lane); continue; } r -= I2;
            if (r < I3) { transpose_item<0>(in[12] + (size_t)l * SW * SW, SW, SW, 0, SW, (bf16*)(wl + WL_GLU), 0, scr, r, C.lane); continue; } r -= I3;
            if (r < I4) { transpose_item<0>(in[14] + (size_t)l * AOUT * DM, AOUT, DM, 0, DM, (bf16*)(wl + WL_ABR), 0, scr, r, C.lane); continue; } r -= I4;
            if (r < I5) { transpose_item<0>(in[15] + (size_t)l * SW * DM, SW, DM, 0, DM, (bf16*)(wl + WL_SBR), 0, scr, r, C.lane); continue; } r -= I5;
            transpose_item<0>(in[16] + (size_t)l * DM * DM, DM, DM, 0, DM, (bf16*)(wl + WL_OUT), 0, scr, r, C.lane); continue; }
        r -= 2 * IL;
        if (r < I7) { transpose_item<1>(in[18], DM, FF, 0, FF, (bf16*)(ws + WS_W13), 0, scr, r, C.lane); continue; } r -= I7;
        if (r < I8) { transpose_item<1>(in[19], DM, FF, 0, FF, (bf16*)(ws + WS_W13), 128, scr, r, C.lane); continue; } r -= I8;
        transpose_item<0>(in[20], FF, DM, 0, DM, (bf16*)(ws + WS_W2), 0, scr, r, C.lane);
    }
}
__device__ __forceinline__ void convert_moe_weights(const Ctx& C, const float* const* in, unsigned char* ws) {
    LAS float* scr = (LAS float*)(C.lds + C.wave * 16384);
    const int gw = C.vcu * NWAVES + C.wave, NGW = C.G * NWAVES;
    constexpr int IG = 16 * 112, ID = 56 * 32, IE = 2 * IG + ID, NITEMS = NEXP * IE;
    for (int it = gw; it < NITEMS; it += NGW) {
        const int e = it / IE; int r = it - e * IE;
        bf16* w13 = (bf16*)(ws + WS_MW13) + (size_t)e * 2 * FFE * DM; bf16* w2 = (bf16*)(ws + WS_MW2) + (size_t)e * DM * FFE;
        if (r < IG) { transpose_item<1>(in[22] + (size_t)e * DM * FFE, DM, FFE, 0, FFE, w13, 0, scr, r, C.lane); continue; } r -= IG;
        if (r < IG) { transpose_item<1>(in[23] + (size_t)e * DM * FFE, DM, FFE, 0, FFE, w13, 128, scr, r, C.lane); continue; } r -= IG;
        transpose_item<0>(in[24] + (size_t)e * FFE * DM, FFE, DM, 0, DM, w2, 0, scr, r, C.lane);
    }
}

__device__ __forceinline__ void norm_rows(const Ctx& C, const float* x, const float* g, bf16* out) {
    const int gw = C.vcu * NWAVES + C.wave, NGW = C.G * NWAVES;
    f32x4 gv[4];
#pragma unroll
    for (int j = 0; j < 4; ++j) gv[j] = ((const f32x4*)g)[C.lane + 64 * j];
    for (int m = gw; m < NTOK; m += NGW) {
        const GAS f32x4* xr = (const GAS f32x4*)(x + (size_t)m * DM) + C.lane;
        f32x4 v[4]; float s = 0.f;
#pragma unroll
        for (int j = 0; j < 4; ++j) { v[j] = xr[64 * j]; s += (v[j].x * v[j].x + v[j].y * v[j].y) + (v[j].z * v[j].z + v[j].w * v[j].w); }
        const float rstd = 1.f / sqrtf(wave_sum(s) * (1.f / DM) + EPS);
        GAS unsigned long long* o8 = (GAS unsigned long long*)(out + (size_t)m * DM) + C.lane;
#pragma unroll
        for (int j = 0; j < 4; ++j) { const f32x4 h = v[j] * rstd * gv[j]; o8[64 * j] = (unsigned long long)pk2(h.x, h.y) | ((unsigned long long)pk2(h.z, h.w) << 32); }
    }
}
__device__ __forceinline__ void attn_decode(int u, int& b, int& gj, int& rs, int& c, int& n) {
    const int bgj = u >> 7, blk = u & 127; b = bgj / 24; gj = bgj - b * 24; const int g = gj >> 3; rs = 2 * g; const int lg = 7 - rs;
    c = blk >> lg; n = blk & ((1 << lg) - 1);
}
__device__ __forceinline__ void attn_phase(const Ctx& C, bf16* Qp, const bf16* Kp, const bf16* Vp, float* LSE, const float* biasg) {
    LAS unsigned char* lds = C.lds;
    constexpr int KOFF = 0, VOFF = 32768, BOFF = VOFF + 272 * 128;
    const int tid = C.tid, lane = C.lane, w = C.wave;
    for (int i = tid; i < 24 * 132; i += 512) ((LAS float*)(lds + BOFF))[i] = biasg[i];
    ((LAS unsigned*)(lds + VOFF + 256 * 128))[tid] = 0u;
    const int u0 = (int)((long)C.vcu * 6144 / C.G), u1 = (int)((long)(C.vcu + 1) * 6144 / C.G);
    const int q15 = lane & 15, g4 = lane >> 4;
    const int srow = tid >> 3, sch = tid & 7;
    v4u kreg[4], vreg[4];
    int b, gj, rs, c, n;
#define ATT_ISSUE(u_) do { attn_decode((u_), b, gj, rs, c, n); \
        _Pragma("unroll") for (int i = 0; i < 4; ++i) { const int kvw = srow + 64 * i; int nb = n - 1 + (kvw >> 7); nb = nb < 0 ? 0 : nb; const int tok = ((128 * nb + (kvw & 127)) << rs) + c; \
            const size_t off = ((size_t)(b * SEQ + tok)) * AW + gj * 64 + sch * 8; kreg[i] = *(const GAS v4u*)(Kp + off); vreg[i] = *(const GAS v4u*)(Vp + off); } } while (0)
    if (u0 < u1) ATT_ISSUE(u0);
    const int kaddr0 = KOFF + (16 * w + q15) * 128 + (((0 + g4) ^ ((q15 >> 1) & 7)) << 4), kaddr1 = KOFF + (16 * w + q15) * 128 + (((4 + g4) ^ ((q15 >> 1) & 7)) << 4);
    const int vrow = 16 * w + 4 * g4 + (q15 >> 2), vswz = (2 * g4 + (q15 >> 3)) & 3;
    int vaddr[4];
#pragma unroll
    for (int db = 0; db < 4; ++db) vaddr[db] = VOFF + vrow * 128 + ((db ^ vswz) << 5) + (q15 & 3) * 8;
    for (int u = u0; u < u1; ++u) {
        __syncthreads();
#pragma unroll
        for (int i = 0; i < 4; ++i) { const int kvw = srow + 64 * i;
            *(LAS v4u*)(lds + KOFF + kvw * 128 + ((sch ^ ((kvw >> 1) & 7)) << 4)) = kreg[i];
            *(LAS v4u*)(lds + VOFF + kvw * 128 + ((((sch >> 1) ^ ((kvw >> 1) & 3)) << 5) | ((sch & 1) << 4))) = vreg[i]; }
        attn_decode(u, b, gj, rs, c, n);
        const int tokq = ((128 * n + 16 * w + q15) << rs) + c;
        bf16* qrow = Qp + ((size_t)(b * SEQ + tokq)) * AW + gj * 64;
        const bf16x8 qf0 = *(const GAS bf16x8*)(qrow + 8 * g4), qf1 = *(const GAS bf16x8*)(qrow + 32 + 8 * g4);
        const int n_cur = n, gj_cur = gj; const size_t tokrow = (size_t)(b * SEQ + tokq);
        __syncthreads();
        if (u + 1 < u1) ATT_ISSUE(u + 1);
        f32x4 s[9];
#pragma unroll
        for (int t = 0; t < 9; ++t) {
            const bf16x8 k0 = *(const LAS bf16x8*)(lds + kaddr0 + t * 2048), k1 = *(const LAS bf16x8*)(lds + kaddr1 + t * 2048);
            f32x4 a = (f32x4){0.f, 0.f, 0.f, 0.f};
            a = __builtin_amdgcn_mfma_f32_16x16x32_bf16(k0, qf0, a, 0, 0, 0);
            s[t] = __builtin_amdgcn_mfma_f32_16x16x32_bf16(k1, qf1, a, 0, 0, 0);
            asm volatile("" : "+v"(s[t]) : "v"(k0), "v"(k1));
        }
        asm volatile("s_nop 15\n\ts_nop 15" : "+v"(s[0]), "+v"(s[1]), "+v"(s[2]), "+v"(s[3]), "+v"(s[4]), "+v"(s[5]), "+v"(s[6]), "+v"(s[7]), "+v"(s[8]));
        const LAS float* bt = (const LAS float*)(lds + BOFF) + gj_cur * 132;
        float mx = -1e30f;
#pragma unroll
        for (int t = 0; t < 9; ++t)
#pragma unroll
            for (int r = 0; r < 4; ++r) { const int kvl = 16 * t + 4 * g4 + r, delta = 128 + q15 - kvl;
                bool valid = (delta >= 0) && (delta <= 128) && !(n_cur == 0 && (16 * w + kvl) < 128);
                const int di = delta < 0 ? 0 : (delta > 128 ? 128 : delta);
                const float v = valid ? s[t][r] + bt[di] : -1e30f; s[t][r] = v; mx = fmaxf(mx, v); }
        mx = fmaxf(mx, __shfl_xor(mx, 16)); mx = fmaxf(mx, __shfl_xor(mx, 32));
        float sum = 0.f;
#pragma unroll
        for (int t = 0; t < 9; ++t)
#pragma unroll
            for (int r = 0; r < 4; ++r) { const float p = __builtin_amdgcn_exp2f(s[t][r] - mx); s[t][r] = p; sum += p; }
        sum += __shfl_xor(sum, 16); sum += __shfl_xor(sum, 32);
        f32x4 o[4];
#pragma unroll
        for (int db = 0; db < 4; ++db) o[db] = (f32x4){0.f, 0.f, 0.f, 0.f};
#pragma unroll
        for (int s5 = 0; s5 < 5; ++s5) {
            v4u pw; pw.x = cvtpk(s[2 * s5][0], s[2 * s5][1]); pw.y = cvtpk(s[2 * s5][2], s[2 * s5][3]);
            if (s5 < 4) { pw.z = cvtpk(s[2 * s5 + 1][0], s[2 * s5 + 1][1]); pw.w = cvtpk(s[2 * s5 + 1][2], s[2 * s5 + 1][3]); } else { pw.z = 0u; pw.w = 0u; }
            const bf16x8 pf = __builtin_bit_cast(bf16x8, pw);
#pragma unroll
            for (int db = 0; db < 4; ++db) {
                const v4i16_t lo = __builtin_amdgcn_ds_read_tr16_b64_v4i16((LAS v4i16_t*)(lds + vaddr[db] + s5 * 4096));
                const v4i16_t hi = __builtin_amdgcn_ds_read_tr16_b64_v4i16((LAS v4i16_t*)(lds + vaddr[db] + s5 * 4096 + 2048));
                const bf16x8 vf = (bf16x8){lo[0], lo[1], lo[2], lo[3], hi[0], hi[1], hi[2], hi[3]};
                o[db] = __builtin_amdgcn_mfma_f32_16x16x32_bf16(vf, pf, o[db], 0, 0, 0);
                asm volatile("" : "+v"(o[db]) : "v"(vf), "v"(pf));
            }
        }
        asm volatile("s_nop 15\n\ts_nop 15" : "+v"(o[0]), "+v"(o[1]), "+v"(o[2]), "+v"(o[3]));
        const float inv = 1.0f / sum;
#pragma unroll
        for (int db = 0; db < 4; ++db) { const unsigned long long wv = (unsigned long long)pk2(o[db][0] * inv, o[db][1] * inv) | ((unsigned long long)pk2(o[db][2] * inv, o[db][3] * inv) << 32);
            *(GAS unsigned long long*)(qrow + 16 * db + 4 * g4) = wv; }
        if (g4 == 0) LSE[tokrow * 24 + gj_cur] = mx + log2f(sum);
    }
#undef ATT_ISSUE
    __syncthreads();
}
__device__ __forceinline__ void attn_combine(const Ctx& C, const bf16* Qp, const float* LSE, bf16* AO) {
    const int gw = C.vcu * NWAVES + C.wave, NGW = C.G * NWAVES, lane = C.lane, j = lane >> 3;
    for (int m = gw; m < NTOK; m += NGW) {
        const float l0 = LSE[(size_t)m * 24 + j], l1 = LSE[(size_t)m * 24 + 8 + j], l2 = LSE[(size_t)m * 24 + 16 + j];
        const float mx = fmaxf(l0, fmaxf(l1, l2)); float w0 = __builtin_amdgcn_exp2f(l0 - mx), w1 = __builtin_amdgcn_exp2f(l1 - mx), w2 = __builtin_amdgcn_exp2f(l2 - mx);
        const float inv = 1.0f / (w0 + w1 + w2); w0 *= inv; w1 *= inv; w2 *= inv;
        const bf16* qr = Qp + (size_t)m * AW + 8 * lane;
        const v4u a = *(const GAS v4u*)qr, bq = *(const GAS v4u*)(qr + 512), cq = *(const GAS v4u*)(qr + 1024);
        v4u o;
#pragma unroll
        for (int k = 0; k < 4; ++k) { const float lo = w0 * pg8::bflo(a[k]) + w1 * pg8::bflo(bq[k]) + w2 * pg8::bflo(cq[k]), hi = w0 * pg8::bfhi(a[k]) + w1 * pg8::bfhi(bq[k]) + w2 * pg8::bfhi(cq[k]); o[k] = pk2(lo, hi); }
        *(GAS v4u*)(AO + (size_t)m * AOUT + 8 * lane) = o;
    }
}

template <bool PASS2>
__device__ __forceinline__ void ssm_pass(const Ctx& C, int layer, const bf16* U, bf16* Z, f32x2v* E, const unsigned char* ws, const float* dskip) {
    LAS unsigned char* wl = C.lds + C.wave * 12800; LAS float* BU = (LAS float*)wl; LAS unsigned char* XS = wl + 8448;
    const int lane = C.lane, p = lane, r16 = lane & 15, kg = lane >> 4;
    const int gwv = C.vcu * NWAVES + C.wave, NGW = C.G * NWAVES;
    const bf16x8 zero8 = (bf16x8){0, 0, 0, 0, 0, 0, 0, 0};
    for (int it = gwv; it < BATCH * SSM_G * NCHUNK; it += NGW) {
        const int bg = it >> 7, k = it & 127, b = bg >> 5, g = bg & 31, gi = layer * SSM_G + g;
        const f32x2v lam = ((const f32x2v*)(ws + TAB_LAMB))[gi * 64 + p];
        bf16x8 bfr[8];
#pragma unroll
        for (int nt = 0; nt < 8; ++nt) { bfr[nt] = zero8; if (kg < 2) bfr[nt] = *(const GAS bf16x8*)((const bf16*)(ws + TAB_BB) + ((size_t)(gi * 128 + 16 * nt + r16)) * 16 + 8 * kg); }
        bf16x8 cfr[4]; float dsk = 0.f;
        float xr = 0.f, xi = 0.f;
        if (PASS2) {
#pragma unroll
            for (int ks = 0; ks < 4; ++ks) cfr[ks] = *(const GAS bf16x8*)((const bf16*)(ws + TAB_CM) + ((size_t)(gi * 16 + r16)) * 128 + 32 * ks + 8 * kg);
            dsk = dskip[16 * g + r16];
            float tr = lam.x, ti = lam.y;
#pragma unroll
            for (int q = 0; q < 7; ++q) { const float nr = tr * tr - ti * ti; ti = 2.f * tr * ti; tr = nr; }
            const f32x2v* Eb = E + ((size_t)bg * NCHUNK) * 64 + p;
            for (int j = 0; j < k; ++j) { const f32x2v e = Eb[(size_t)j * 64]; const float nr = tr * xr - ti * xi + e.x; xi = tr * xi + ti * xr + e.y; xr = nr; }
        }
        for (int sub = 0; sub < 8; ++sub) {
            const int tok0 = b * SEQ + k * CHUNK + sub * 16;
            bf16x8 a = zero8; if (kg < 2) a = *(const GAS bf16x8*)(U + (size_t)(tok0 + r16) * SW + 16 * g + 8 * kg);
            f32x4 dd[8];
#pragma unroll
            for (int nt = 0; nt < 8; ++nt) dd[nt] = __builtin_amdgcn_mfma_f32_16x16x32_bf16(a, bfr[nt], (f32x4){0.f, 0.f, 0.f, 0.f}, 0, 0, 0);
            asm volatile("s_nop 15\n\ts_nop 15" : "+v"(dd[0]), "+v"(dd[1]), "+v"(dd[2]), "+v"(dd[3]), "+v"(dd[4]), "+v"(dd[5]), "+v"(dd[6]), "+v"(dd[7]) : "v"(a));
#pragma unroll
            for (int nt = 0; nt < 8; ++nt)
#pragma unroll
                for (int r = 0; r < 4; ++r) BU[(4 * kg + r) * 132 + 16 * nt + r16] = dd[nt][r];
#pragma unroll
            for (int t = 0; t < 16; ++t) { const f32x2v bu = *(const LAS f32x2v*)(BU + t * 132 + 2 * p);
                const float nr = lam.x * xr - lam.y * xi + bu.x; xi = lam.x * xi + lam.y * xr + bu.y; xr = nr;
                if (PASS2) *(LAS unsigned*)(XS + t * 272 + 4 * p) = cvtpk(xr, xi); }
            if (PASS2) {
                f32x4 y = (f32x4){0.f, 0.f, 0.f, 0.f};
#pragma unroll
                for (int ks = 0; ks < 4; ++ks) { const bf16x8 afr = *(const LAS bf16x8*)(XS + r16 * 272 + 64 * ks + 16 * kg); y = __builtin_amdgcn_mfma_f32_16x16x32_bf16(afr, cfr[ks], y, 0, 0, 0); asm volatile("" : "+v"(y) : "v"(afr)); }
                asm volatile("s_nop 15\n\ts_nop 15" : "+v"(y));
#pragma unroll
                for (int r = 0; r < 4; ++r) { const size_t idx = (size_t)(tok0 + 4 * kg + r) * SW + 16 * g + r16; const float yy = y[r] + dsk * bf2f(U[idx]);
                    const float z = yy * sigm_f(1.5957691216057308f * (yy + 0.044715f * yy * yy * yy)); Z[idx] = (bf16)f2bf(z); }
            }
        }
        if (!PASS2) E[((size_t)bg * NCHUNK + k) * 64 + p] = (f32x2v){xr, xi};
    }
}
constexpr int ROUTE_LDS = 12288;
__device__ __forceinline__ void route_pass1(const Ctx& C, const float* x, const float* g2, const float* wrouter, unsigned char* ws) {
    const int TPW = NTOK / C.G, t0 = C.vcu * TPW, lane = C.lane;
    LAS int* te = (LAS int*)(C.lds + ROUTE_LDS); LAS f32x2v* tg = (LAS f32x2v*)(C.lds + ROUTE_LDS + 1024); LAS int* lcnt = (LAS int*)(C.lds + ROUTE_LDS + 3072);
    if (C.tid < 8) lcnt[C.tid] = 0;
    f32x4 gv[4];
#pragma unroll
    for (int j = 0; j < 4; ++j) gv[j] = ((const f32x4*)g2)[lane + 64 * j];
    for (int r = C.wave; r < TPW; r += NWAVES) {
        const GAS f32x4* xr = (const GAS f32x4*)(x + (size_t)(t0 + r) * DM) + lane;
        f32x4 v[4]; float s = 0.f;
#pragma unroll
        for (int j = 0; j < 4; ++j) { v[j] = xr[64 * j]; s += (v[j].x * v[j].x + v[j].y * v[j].y) + (v[j].z * v[j].z + v[j].w * v[j].w); }
        const float rstd = 1.f / sqrtf(wave_sum(s) * (1.f / DM) + EPS);
        float lg[8];
#pragma unroll
        for (int e = 0; e < 8; ++e) lg[e] = 0.f;
#pragma unroll
        for (int j = 0; j < 4; ++j) { const f32x4 h = v[j] * rstd * gv[j];
#pragma unroll
            for (int i = 0; i < 4; ++i) { const GAS f32x4* wp = (const GAS f32x4*)(wrouter + (size_t)(4 * lane + 256 * j + i) * 8); const f32x4 wa = wp[0], wb = wp[1];
                lg[0] += h[i] * wa.x; lg[1] += h[i] * wa.y; lg[2] += h[i] * wa.z; lg[3] += h[i] * wa.w; lg[4] += h[i] * wb.x; lg[5] += h[i] * wb.y; lg[6] += h[i] * wb.z; lg[7] += h[i] * wb.w; } }
#pragma unroll
        for (int e = 0; e < 8; ++e) lg[e] = wave_sum(lg[e]);
        if (lane == 0) {
            int e0 = 0; float v0 = lg[0];
#pragma unroll
            for (int e = 1; e < 8; ++e) if (lg[e] > v0) { v0 = lg[e]; e0 = e; }
            int e1 = -1; float v1 = -3.0e38f;
#pragma unroll
            for (int e = 0; e < 8; ++e) if (e != e0 && lg[e] > v1) { v1 = lg[e]; e1 = e; }
            const float g0 = 1.0f / (1.0f + expf(v1 - v0));
            te[r] = e0 | (e1 << 8); tg[r] = (f32x2v){g0, 1.0f - g0};
        }
    }
    __syncthreads();
    if (C.tid == 0) { for (int t = 0; t < TPW; ++t) { const int e = te[t]; const int r0 = lcnt[e & 255]; lcnt[e & 255] = r0 + 1; const int r1 = lcnt[e >> 8]; lcnt[e >> 8] = r1 + 1; const int tok = t0 + t;
        ((int*)(ws + TOK_E))[tok] = e; ((i32x2v*)(ws + TOK_R))[tok] = (i32x2v){r0, r1}; ((f32x2v*)(ws + TOK_G))[tok] = tg[t]; } }
    __syncthreads();
    if (C.tid < 8) ((int*)(ws + CNTWG))[C.vcu * 8 + C.tid] = lcnt[C.tid];
}
__device__ __forceinline__ void moe_bases(const Ctx& C, const unsigned char* ws) {
    LAS int* ctl = (LAS int*)(C.lds + LDSCTL_OFF);
    __syncthreads();
    if (C.tid < 8) { const int* cw = (const int*)(ws + CNTWG); int tot = 0, mine = 0;
        for (int w = 0; w < C.G; ++w) { const int cv = __hip_atomic_load(cw + w * 8 + C.tid, __ATOMIC_RELAXED, __HIP_MEMORY_SCOPE_AGENT); if (w < C.vcu) mine += cv; tot += cv; }
        ctl[32 + C.tid] = tot; ctl[40 + C.tid] = mine; }
    __syncthreads();
    if (C.tid == 0) { int tb = 0; for (int e = 0; e < 8; ++e) { ctl[e] = tb; ctl[16 + e] = tb * 256 + ctl[40 + e]; tb += (ctl[32 + e] + 255) >> 8; } ctl[8] = tb; }
    __syncthreads();
}
__device__ __forceinline__ void route_pass2(const Ctx& C, const float* x, const float* g2, unsigned char* ws) {
    const int TPW = NTOK / C.G, t0 = C.vcu * TPW, lane = C.lane;
    LAS int* ctl = (LAS int*)(C.lds + LDSCTL_OFF); LAS i32x2v* sl = (LAS i32x2v*)(C.lds + ROUTE_LDS);
    moe_bases(C, ws);
    if (C.tid < TPW) { const int tok = t0 + C.tid; const int e = ((const int*)(ws + TOK_E))[tok]; const i32x2v r = ((const i32x2v*)(ws + TOK_R))[tok];
        const i32x2v s = (i32x2v){ctl[16 + (e & 255)] + r.x, ctl[16 + (e >> 8)] + r.y}; ((i32x2v*)(ws + TOK_S))[tok] = s; sl[C.tid] = s; }
    __syncthreads();
    f32x4 gv[4];
#pragma unroll
    for (int j = 0; j < 4; ++j) gv[j] = ((const f32x4*)g2)[lane + 64 * j];
    bf16* XS = (bf16*)(ws + WS_XS);
    for (int r = C.wave; r < TPW; r += NWAVES) {
        const GAS f32x4* xr = (const GAS f32x4*)(x + (size_t)(t0 + r) * DM) + lane;
        f32x4 v[4]; float s = 0.f;
#pragma unroll
        for (int j = 0; j < 4; ++j) { v[j] = xr[64 * j]; s += (v[j].x * v[j].x + v[j].y * v[j].y) + (v[j].z * v[j].z + v[j].w * v[j].w); }
        const float rstd = 1.f / sqrtf(wave_sum(s) * (1.f / DM) + EPS);
        const i32x2v st = sl[r];
        GAS unsigned long long* o0 = (GAS unsigned long long*)(XS + (size_t)st.x * DM) + lane; GAS unsigned long long* o1 = (GAS unsigned long long*)(XS + (size_t)st.y * DM) + lane;
#pragma unroll
        for (int j = 0; j < 4; ++j) { const f32x4 h = v[j] * rstd * gv[j]; const unsigned long long wv = (unsigned long long)pk2(h.x, h.y) | ((unsigned long long)pk2(h.z, h.w) << 32); o0[64 * j] = wv; o1[64 * j] = wv; }
    }
}
__device__ __forceinline__ void final_rows(const Ctx& C, float* x, const float* fg, const unsigned char* ws) {
    const int gw = C.vcu * NWAVES + C.wave, NGW = C.G * NWAVES, lane = C.lane;
    f32x4 gv[4];
#pragma unroll
    for (int j = 0; j < 4; ++j) gv[j] = ((const f32x4*)fg)[lane + 64 * j];
    const bf16* XS = (const bf16*)(ws + WS_XS);
    for (int m = gw; m < NTOK; m += NGW) {
        const i32x2v st = ((const i32x2v*)(ws + TOK_S))[m]; const f32x2v gt = ((const f32x2v*)(ws + TOK_G))[m];
        GAS f32x4* xr = (GAS f32x4*)(x + (size_t)m * DM) + lane;
        const GAS unsigned long long* y0 = (const GAS unsigned long long*)(XS + (size_t)st.x * DM) + lane; const GAS unsigned long long* y1 = (const GAS unsigned long long*)(XS + (size_t)st.y * DM) + lane;
        f32x4 v[4]; float s = 0.f;
#pragma unroll
        for (int j = 0; j < 4; ++j) { v[j] = xr[64 * j]; const unsigned long long a = y0[64 * j], bq = y1[64 * j];
            const unsigned a0 = (unsigned)a, a1 = (unsigned)(a >> 32), b0 = (unsigned)bq, b1 = (unsigned)(bq >> 32);
            v[j].x += gt.x * pg8::bflo(a0) + gt.y * pg8::bflo(b0); v[j].y += gt.x * pg8::bfhi(a0) + gt.y * pg8::bfhi(b0);
            v[j].z += gt.x * pg8::bflo(a1) + gt.y * pg8::bflo(b1); v[j].w += gt.x * pg8::bfhi(a1) + gt.y * pg8::bfhi(b1);
            s += (v[j].x * v[j].x + v[j].y * v[j].y) + (v[j].z * v[j].z + v[j].w * v[j].w); }
        const float rstd = 1.f / sqrtf(wave_sum(s) * (1.f / DM) + EPS);
#pragma unroll
        for (int j = 0; j < 4; ++j) xr[64 * j] = v[j] * rstd * gv[j];
    }
}
struct MoeOrder {
    pg8::StaticOrder so; int t0; int tb1, tb2, tb3, tb4, tb5, tb6, tb7; size_t estride;
    __device__ __forceinline__ bool next(int i, pg8::Unit& u) const {
        if (!so.next(i, u)) return false;
        u.pm += t0; const int e = (u.pm >= tb1) + (u.pm >= tb2) + (u.pm >= tb3) + (u.pm >= tb4) + (u.pm >= tb5) + (u.pm >= tb6) + (u.pm >= tb7);
        u.boff = (size_t)e * estride; return true;
    }
    __device__ __forceinline__ void a_ready(const pg8::Unit&) const {}
    __device__ __forceinline__ void done(const pg8::Unit&) const {}
};
#ifndef MK_SPLIT
#define MK_SPLIT 1
#endif
struct Args { const float* in[26]; float* out; unsigned char* ws; int l, p; };
__device__ __forceinline__ void make_ctx(Ctx& C, unsigned char* lds_raw) { int t_ = threadIdx.x; asm volatile("" : "+v"(t_));
    C.lds = (LAS unsigned char*)lds_raw; C.tid = t_; C.lane = t_ & 63; C.wave = __builtin_amdgcn_readfirstlane(t_ >> 6);
    C.G = gridDim.x; { const int bx = blockIdx.x; C.vcu = (C.G % 8 == 0) ? (bx % 8) * (C.G / 8) + bx / 8 : bx; } }
enum { PH_P0 = 0, PH_A, PH_B, PH_C, PH_D, PH_E, PH_F, PH_N2, PH_FUP, PH_FDN, PH_N1, PH_R1, PH_R2, PH_MOE, PH_FIN, PH_COUNT };
template <int PH> __device__ __forceinline__ void run_phase(unsigned char* lds_raw, const float* const* in, float* out, unsigned char* ws, int l, int p) {
    Ctx C; make_ctx(C, lds_raw);
    LAS unsigned char* ring = C.lds;
    unsigned char* wl = ws + WS_WS + (size_t)l * WL_STRIDE;
    bf16* Hb = (bf16*)(ws + WS_H); bf16* QP = (bf16*)(ws + WS_QP); bf16* KP = (bf16*)(ws + WS_KP); bf16* VP = (bf16*)(ws + WS_VP);
    bf16* Ub = (bf16*)(ws + WS_U); bf16* Zb = (bf16*)(ws + WS_Z); bf16* AOb = (bf16*)(ws + WS_AO); bf16* Gb = (bf16*)(ws + WS_G); bf16* Mb = (bf16*)(ws + WS_M); bf16* ZGb = (bf16*)(ws + WS_ZG);
    float* LSE = (float*)(ws + WS_LSE); f32x2v* Eb = (f32x2v*)(ws + WS_E);
    if constexpr (PH == PH_P0) {
        build_tables(C, in[1], in[4], in[5], in[6], in[7], in[8], in[9], in[10], ws);
        convert_small_weights(C, in, ws);
        norm_rows(C, in[0], in[2], Hb);
    } else if constexpr (PH == PH_A) {
        pg8::Gemm g{Hb, (const bf16*)(wl + WL_QKVU), NTOK, NQKVU, DM}; pg8::StaticOrder S; S.init(NTOK, NQKVU, C.G, (int)blockIdx.x);
        pg8::EpiProj E{QP, KP, VP, Ub, 0.125f * LOG2E};
        pg8::gemm_phase<pg8::EpiProj, pg8::StaticOrder, true, true>(ring, g, S, E);
    } else if constexpr (PH == PH_B) {
        attn_phase(C, QP, KP, VP, LSE, (const float*)(ws + TAB_BIAS));
        ssm_pass<false>(C, l, Ub, nullptr, Eb, ws, nullptr);
    } else if constexpr (PH == PH_C) {
        ssm_pass<true>(C, l, Ub, Zb, Eb, ws, in[11] + (size_t)l * SW);
        attn_combine(C, QP, LSE, AOb);
        __syncthreads();
        pg8::Gemm g{Hb, (const bf16*)(wl + WL_G), NTOK, NGATE, DM}; pg8::StaticOrder S; S.init(NTOK, NGATE, C.G, (int)blockIdx.x);
        pg8::EpiSig E{Gb, NGATE};
        pg8::gemm_phase<pg8::EpiSig, pg8::StaticOrder, true, true>(ring, g, S, E);
    } else if constexpr (PH == PH_D) {
        pg8::Gemm g{Zb, (const bf16*)(wl + WL_GLU), NTOK, SW, SW}; pg8::StaticOrder S; S.init(NTOK, SW, C.G, (int)blockIdx.x);
        pg8::EpiGlu E{Zb, ZGb, SW, in[13] + (size_t)l * SW};
        pg8::gemm_phase<pg8::EpiGlu, pg8::StaticOrder, true, true>(ring, g, S, E);
    } else if constexpr (PH == PH_E) {
        { pg8::Gemm g{AOb, (const bf16*)(wl + WL_ABR), NTOK, DM, AOUT}; pg8::StaticOrder S; S.init(NTOK, DM, C.G, (int)blockIdx.x);
          pg8::EpiGate<0> E{Gb, NGATE, 0, Mb, DM};
          pg8::gemm_phase<pg8::EpiGate<0>, pg8::StaticOrder, true, true>(ring, g, S, E); }
        asm volatile("s_waitcnt vmcnt(0)" ::: "memory"); __syncthreads();
        { pg8::Gemm g{ZGb, (const bf16*)(wl + WL_SBR), NTOK, DM, SW}; pg8::StaticOrder S; S.init(NTOK, DM, C.G, (int)blockIdx.x);
          pg8::EpiGate<1> E{Gb, NGATE, DM, Mb, DM};
          pg8::gemm_phase<pg8::EpiGate<1>, pg8::StaticOrder, true, true>(ring, g, S, E); }
    } else if constexpr (PH == PH_F) {
        pg8::Gemm g{Mb, (const bf16*)(wl + WL_OUT), NTOK, DM, DM}; pg8::StaticOrder S; S.init(NTOK, DM, C.G, (int)blockIdx.x);
        pg8::EpiResid E{l == 0 ? in[0] : out, out, DM};
        pg8::gemm_phase<pg8::EpiResid, pg8::StaticOrder, true, true>(ring, g, S, E);
    } else if constexpr (PH == PH_N2) {
        norm_rows(C, out, in[17], Hb);
    } else if constexpr (PH == PH_FUP) {
        pg8::Gemm g{Hb, (const bf16*)(ws + WS_W13), NTOK, 2 * FF, DM}; pg8::StaticOrder S; S.init(NTOK, 2 * FF, C.G, (int)blockIdx.x);
        pg8::EpiSwiGlu E{(bf16*)(ws + WS_HID), FF};
        pg8::gemm_phase<pg8::EpiSwiGlu, pg8::StaticOrder, true, true>(ring, g, S, E);
    } else if constexpr (PH == PH_FDN) {
        pg8::Gemm g{(const bf16*)(ws + WS_HID), (const bf16*)(ws + WS_W2), NTOK, DM, FF}; pg8::StaticOrder S; S.init(NTOK, DM, C.G, (int)blockIdx.x);
        pg8::EpiResid E{out, out, DM};
        pg8::gemm_phase<pg8::EpiResid, pg8::StaticOrder, true, true>(ring, g, S, E);
    } else if constexpr (PH == PH_N1) {
        norm_rows(C, out, in[2] + DM, Hb);
    } else if constexpr (PH == PH_R1) {
        convert_moe_weights(C, in, ws); __syncthreads(); route_pass1(C, out, in[17] + DM, in[21], ws);
    } else if constexpr (PH == PH_R2) {
        route_pass2(C, out, in[17] + DM, ws);
    } else if constexpr (PH == PH_MOE) {
        moe_bases(C, ws);
        const LAS int* tbl = (const LAS int*)(C.lds + LDSCTL_OFF);
        const int tb1 = __builtin_amdgcn_readfirstlane(tbl[1]), tb2 = __builtin_amdgcn_readfirstlane(tbl[2]), tb3 = __builtin_amdgcn_readfirstlane(tbl[3]), tb4 = __builtin_amdgcn_readfirstlane(tbl[4]),
                  tb5 = __builtin_amdgcn_readfirstlane(tbl[5]), tb6 = __builtin_amdgcn_readfirstlane(tbl[6]), tb7 = __builtin_amdgcn_readfirstlane(tbl[7]), nT = __builtin_amdgcn_readfirstlane(tbl[8]);
        if (p >= 1) {
            const int cc = p - 1, t0 = cc * MOE_CHUNK_TILES; int ntc = nT - t0; ntc = ntc < 0 ? 0 : (ntc > MOE_CHUNK_TILES ? MOE_CHUNK_TILES : ntc);
            const bf16* hid = (const bf16*)(ws + ((cc & 1) ? WS_HID1 : WS_HID0)) - (size_t)t0 * 256 * FFE;
            pg8::Gemm g{hid, (const bf16*)(ws + WS_MW2), ntc * 256, DM, FFE};
            MoeOrder S; S.so.init(ntc * 256, DM, C.G, (int)blockIdx.x); S.t0 = t0; S.tb1 = tb1; S.tb2 = tb2; S.tb3 = tb3; S.tb4 = tb4; S.tb5 = tb5; S.tb6 = tb6; S.tb7 = tb7; S.estride = (size_t)DM * FFE * 2;
            pg8::EpiPlain E{(bf16*)(ws + WS_XS), DM};
            pg8::gemm_phase<pg8::EpiPlain, MoeOrder, true, true>(ring, g, S, E);
        }
        if (p < MOE_NCHUNK) {
            const int cc = p, t0 = cc * MOE_CHUNK_TILES; int ntc = nT - t0; ntc = ntc < 0 ? 0 : (ntc > MOE_CHUNK_TILES ? MOE_CHUNK_TILES : ntc);
            bf16* hid = (bf16*)(ws + ((cc & 1) ? WS_HID1 : WS_HID0)) - (size_t)t0 * 256 * FFE;
            pg8::Gemm g{(const bf16*)(ws + WS_XS), (const bf16*)(ws + WS_MW13), ntc * 256, 2 * FFE, DM};
            MoeOrder S; S.so.init(ntc * 256, 2 * FFE, C.G, (int)blockIdx.x); S.t0 = t0; S.tb1 = tb1; S.tb2 = tb2; S.tb3 = tb3; S.tb4 = tb4; S.tb5 = tb5; S.tb6 = tb6; S.tb7 = tb7; S.estride = (size_t)2 * FFE * DM * 2;
            pg8::EpiSwiGlu E{hid, FFE};
            pg8::gemm_phase<pg8::EpiSwiGlu, MoeOrder, true, true>(ring, g, S, E);
        }
    } else if constexpr (PH == PH_FIN) {
        final_rows(C, out, in[25], ws);
    }
}
template <int PH> __global__ void __launch_bounds__(NWAVES * 64, 2) phase_kernel(Args args) {
    extern __shared__ __attribute__((aligned(16))) unsigned char lds_raw[];
    for (int u = threadIdx.x; u < (LDS_BYTES - LDSCTL_OFF) / 4; u += NWAVES * 64) ((LAS unsigned*)((LAS unsigned char*)lds_raw + LDSCTL_OFF))[u] = 0u;
    __syncthreads();
    run_phase<PH>(lds_raw, args.in, args.out, args.ws, args.l, args.p);
}
__global__ void __launch_bounds__(NWAVES * 64, 2) mega_fwd(Args args) {
    extern __shared__ __attribute__((aligned(16))) unsigned char lds_raw[];
    for (int u = threadIdx.x; u < (LDS_BYTES - LDSCTL_OFF) / 4; u += NWAVES * 64) ((LAS unsigned*)((LAS unsigned char*)lds_raw + LDSCTL_OFF))[u] = 0u;
    __syncthreads();
    unsigned char* ws = args.ws;
    gu32* ctl = (gu32*)(ws + WS_CTL);
    volatile LAS unsigned* MISC = (volatile LAS unsigned*)((LAS unsigned char*)lds_raw + MISC_OFF);
    const XcdBarrier bar = xcd_barrier_post((unsigned*)(ctl + CW_BAR), MISC + 8);
    const float* const* in = args.in; float* out = args.out;
#define PHASE(PH, l_, p_) do { run_phase<PH>(lds_raw, in, out, ws, (l_), (p_)); } while (0)
#define SEAM xcd_barrier(bar)
    PHASE(PH_P0, 0, 0); SEAM;
    for (int l = 0; l < 2; ++l) {
        PHASE(PH_A, l, 0); SEAM; PHASE(PH_B, l, 0); SEAM; PHASE(PH_C, l, 0); SEAM; PHASE(PH_D, l, 0); SEAM; PHASE(PH_E, l, 0); SEAM; PHASE(PH_F, l, 0); SEAM;
        if (l == 0) { PHASE(PH_N2, 0, 0); SEAM; PHASE(PH_FUP, 0, 0); SEAM; PHASE(PH_FDN, 0, 0); SEAM; PHASE(PH_N1, 0, 0); SEAM; }
        else { PHASE(PH_R1, 1, 0); SEAM; PHASE(PH_R2, 1, 0); SEAM;
            for (int p = 0; p <= MOE_NCHUNK; ++p) { PHASE(PH_MOE, 1, p); SEAM; }
            PHASE(PH_FIN, 1, 0); }
    }
#undef PHASE
#undef SEAM
}

template <int PH> static void launch_phase(const Args& a, int l, int p, int grid, hipStream_t stream) {
    static bool attr_set = false;
    if (!attr_set) { (void)hipFuncSetAttribute((const void*)phase_kernel<PH>, hipFuncAttributeMaxDynamicSharedMemorySize, LDS_BYTES); attr_set = true; }
    Args b = a; b.l = l; b.p = p;
    hipLaunchKernelGGL(phase_kernel<PH>, dim3(grid), dim3(NWAVES * 64), LDS_BYTES, stream, b);
}
extern "C" void kernel_launch(void* const* d_in, const int* in_sizes, int n_in, void* d_out, int out_size, void* d_ws, size_t ws_size, hipStream_t stream) {
    static int grid = 0;
    if (grid == 0) {
        if (n_in != 26 || in_sizes[0] != NTOK * DM || out_size != NTOK * DM || ws_size < WS_END) { fprintf(stderr, "kernel_launch: unexpected shapes (n_in %d, in0 %d, out %d, ws %zu); nothing launched\n", n_in, n_in > 0 ? in_sizes[0] : -1, out_size, ws_size); grid = -1; return; }
        int dev = 0, cus = 0, per_cu = 0;
        if (hipGetDevice(&dev) != hipSuccess || hipDeviceGetAttribute(&cus, hipDeviceAttributeMultiprocessorCount, dev) != hipSuccess) { grid = -1; return; }
        if (hipFuncSetAttribute((const void*)mega_fwd, hipFuncAttributeMaxDynamicSharedMemorySize, LDS_BYTES) != hipSuccess) { fprintf(stderr, "kernel_launch: hipFuncSetAttribute failed\n"); grid = -1; return; }
        if (hipOccupancyMaxActiveBlocksPerMultiprocessor(&per_cu, (const void*)mega_fwd, NWAVES * 64, LDS_BYTES) != hipSuccess || per_cu < 1)
            fprintf(stderr, "kernel_launch: note: occupancy query reports %d workgroups per CU\n", per_cu);
        (void)hipGetLastError();
        grid = cus;
        if (grid != 256) { fprintf(stderr, "kernel_launch: %d CUs; this kernel is laid out for 256\n", cus); grid = 256; }
    }
    if (grid < 0) return;
    if (hipMemsetAsync((char*)d_ws + WS_CTL, 0, CTL_ZERO_BYTES, stream) != hipSuccess) return;
    Args a{};
    for (int i = 0; i < 26; ++i) a.in[i] = (const float*)d_in[i];
    a.out = (float*)d_out; a.ws = (unsigned char*)d_ws; a.l = 0; a.p = 0;
#if MK_SPLIT
    launch_phase<PH_P0>(a, 0, 0, grid, stream);
    for (int l = 0; l < 2; ++l) {
        launch_phase<PH_A>(a, l, 0, grid, stream); launch_phase<PH_B>(a, l, 0, grid, stream); launch_phase<PH_C>(a, l, 0, grid, stream);
        launch_phase<PH_D>(a, l, 0, grid, stream); launch_phase<PH_E>(a, l, 0, grid, stream); launch_phase<PH_F>(a, l, 0, grid, stream);
        if (l == 0) { launch_phase<PH_N2>(a, 0, 0, grid, stream); launch_phase<PH_FUP>(a, 0, 0, grid, stream); launch_phase<PH_FDN>(a, 0, 0, grid, stream); launch_phase<PH_N1>(a, 0, 0, grid, stream); }
        else { launch_phase<PH_R1>(a, 1, 0, grid, stream); launch_phase<PH_R2>(a, 1, 0, grid, stream);
            for (int p = 0; p <= MOE_NCHUNK; ++p) launch_phase<PH_MOE>(a, 1, p, grid, stream);
            launch_phase<PH_FIN>(a, 1, 0, grid, stream); }
    }
#else
    hipLaunchKernelGGL(mega_fwd, dim3(grid), dim3(NWAVES * 64), LDS_BYTES, stream, a);
#endif
    const hipError_t le = hipPeekAtLastError();
    if (le != hipSuccess) fprintf(stderr, "kernel_launch: launch failed: %s\n", hipGetErrorName(le));
}
```

```cpp
#include <hip/hip_runtime.h>
#include <cstdio>
#include <cstdint>
namespace pg8 {
#define PG8_LAS __attribute__((address_space(3)))
typedef unsigned short bf16_t;
typedef short bf16x8 __attribute__((ext_vector_type(8)));
typedef float f32x4 __attribute__((ext_vector_type(4)));
typedef unsigned u32x4 __attribute__((ext_vector_type(4)));
constexpr int BM = 256, BK = 64, HALF = 128, HTB = HALF * BK * 2  , STAGE_BYTES = 8 * HTB, NXCD = 8, WGM = 8;

__host__ __device__ __forceinline__ int lds_byte(int r, int c) { const int st = (r >> 4) * 2 + (c >> 5), rr = r & 15, cc = c & 31, ob = rr * 64 + cc * 2; return st * 1024 + (ob ^ (((ob >> 9) & 1) << 5)); }
__host__ __device__ __forceinline__ void stage_rc(int b, int& R, int& C) { const int st = b / 1024, sb = b % 1024, swz = sb ^ (((sb >> 9) & 1) << 5); R = (st >> 1) * 16 + swz / 64; C = (st & 1) * 32 + (swz % 64) / 2; }
__host__ __device__ __forceinline__ int perm32(int rho) { const int n = rho >> 4, i = rho & 15; return 8 * (i >> 2) + 4 * n + (i & 3); }

struct Unit { int pm, pn; size_t boff; };
struct Gemm { const bf16_t* A; const bf16_t* Bt; int M, N, K; int sw, sa; };
typedef int pg8_v8i __attribute__((ext_vector_type(8))); typedef int pg8_v4i __attribute__((ext_vector_type(4)));
__device__ __forceinline__ pg8_v8i pg8_cat(bf16x8 lo, bf16x8 hi) { return __builtin_shufflevector(__builtin_bit_cast(pg8_v4i, lo), __builtin_bit_cast(pg8_v4i, hi), 0, 1, 2, 3, 4, 5, 6, 7); }

struct StaticOrder {
    int nM, nN, nwg, G, c;
    __host__ __device__ void init(int M, int N, int G_, int c_) { nM = M / BM; nN = N / BM; nwg = nM * nN; G = G_; c = c_; }
    __host__ __device__ bool next(int i, Unit& u) const {
        const long L = (long)i * G + c; if (L >= nwg) return false;
        int wgid = (int)L; { const int q = nwg / NXCD, r = nwg % NXCD, xcd = wgid % NXCD, off = wgid / NXCD; wgid = (xcd < r ? xcd * (q + 1) : r * (q + 1) + (xcd - r) * q) + off; }
        const int nig = WGM * nN, gid = wgid / nig, fm = gid * WGM, gsz = (nM - fm) < WGM ? (nM - fm) : WGM;
        u.pm = fm + ((wgid % nig) % gsz); u.pn = (wgid % nig) / gsz; u.boff = 0; return true;
    }
    __device__ __forceinline__ void a_ready(const Unit&) const {}
    __device__ __forceinline__ void done(const Unit&) const {}
};

typedef float f32x2c_t __attribute__((ext_vector_type(2))); typedef __bf16 bf16x2c_t __attribute__((ext_vector_type(2)));
__device__ __forceinline__ unsigned cvt_pk_bf16(float lo, float hi) { const f32x2c_t v = {lo, hi}; const bf16x2c_t b = __builtin_convertvector(v, bf16x2c_t); return __builtin_bit_cast(unsigned, b); }
typedef float f32x2 __attribute__((ext_vector_type(2)));
__device__ __forceinline__ f32x2 gelu_pk(f32x2 v) {
    const f32x2 av = __builtin_elementwise_abs(v), d = av * 0.2316418882f + 1.0f;
    f32x2 t; t.x = __builtin_amdgcn_rcpf(d.x); t.y = __builtin_amdgcn_rcpf(d.y);
    f32x2 q = t * 0.5307027145f + (-0.7265760135f); q = q * t + 0.7107068705f; q = q * t + (-0.142248368f); q = q * t + 0.127414796f; q = q * t;
    const f32x2 s = (v * v) * (-0.72134752044f);
    f32x2 e; e.x = __builtin_amdgcn_exp2f(s.x); e.y = __builtin_amdgcn_exp2f(s.y);
    const f32x2 m = v * (q * e), r = v - m;
    f32x2 o; o.x = v.x < 0.f ? m.x : r.x; o.y = v.y < 0.f ? m.y : r.y; return o;
}

template <int ACT  > struct EpiBf16 {
    static constexpr bool PERM = true, AFTER_DRAIN = false; static_assert(ACT == 0 || ACT == 1, "EpiBf16: ACT is 0 (none) or 1 (gelu_pk)");
    bf16_t* O; int ldc; const float* bias; int split_cols; size_t split_stride; float scale0;
    __device__ __forceinline__ void operator()(const f32x4 (&acc)[2][2][4][2], const Unit& u, int wr, int wc, int fr, int fq) const {
        const int row0 = u.pm * BM + wr * 64 + fr; int colt = u.pn * BM; bf16_t* base = O;
        float sc = 1.f; if (split_cols) { const int t = colt / split_cols; base += (size_t)t * split_stride; colt -= t * split_cols; if (t == 0) sc = scale0; }
        const int col0 = colt + wc * 32 + 8 * fq, bcol0 = u.pn * BM + wc * 32 + 8 * fq;
        f32x4 bv[2][2];
#pragma unroll
        for (int bj = 0; bj < 2; ++bj)
#pragma unroll
            for (int n = 0; n < 2; ++n) bv[bj][n] = bias ? *(const f32x4*)(bias + bcol0 + bj * HALF + 4 * n) : (f32x4){0.f, 0.f, 0.f, 0.f};
#pragma unroll
        for (int ai = 0; ai < 2; ++ai)
#pragma unroll
            for (int m = 0; m < 4; ++m) { bf16_t* rowp = base + (size_t)(row0 + ai * HALF + m * 16) * ldc + col0;
#pragma unroll
                for (int bj = 0; bj < 2; ++bj) { f32x4 v0 = acc[ai][bj][m][0] + bv[bj][0], v1 = acc[ai][bj][m][1] + bv[bj][1];
                    if (ACT == 1) { f32x2 a = gelu_pk((f32x2){v0[0], v0[1]}), b = gelu_pk((f32x2){v0[2], v0[3]}), c = gelu_pk((f32x2){v1[0], v1[1]}), d = gelu_pk((f32x2){v1[2], v1[3]});
                        v0 = (f32x4){a.x, a.y, b.x, b.y}; v1 = (f32x4){c.x, c.y, d.x, d.y}; }
                    v0 = v0 * sc; v1 = v1 * sc; u32x4 w; w.x = cvt_pk_bf16(v0[0], v0[1]); w.y = cvt_pk_bf16(v0[2], v0[3]); w.z = cvt_pk_bf16(v1[0], v1[1]); w.w = cvt_pk_bf16(v1[2], v1[3]);
                    *(u32x4*)(rowp + bj * HALF) = w; } }
    }
};

__device__ __forceinline__ float sigm(float x) { return __builtin_amdgcn_rcpf(1.0f + __builtin_amdgcn_exp2f(-1.4426950408889634f * x)); }
__device__ __forceinline__ float bflo(unsigned w) { return __uint_as_float(w << 16); }
__device__ __forceinline__ float bfhi(unsigned w) { return __uint_as_float(w & 0xffff0000u); }
__device__ __forceinline__ unsigned pk4_fp8(float a, float b, float c, float d) { unsigned w = 0u; w = __builtin_amdgcn_cvt_pk_fp8_f32(a, b, w, false); w = __builtin_amdgcn_cvt_pk_fp8_f32(c, d, w, true); return w; }
__device__ __forceinline__ void st8(bf16_t* p, f32x4 v0, f32x4 v1) { u32x4 w; w.x = cvt_pk_bf16(v0[0], v0[1]); w.y = cvt_pk_bf16(v0[2], v0[3]); w.z = cvt_pk_bf16(v1[0], v1[1]); w.w = cvt_pk_bf16(v1[2], v1[3]); *(u32x4*)p = w; }
__device__ __forceinline__ void ld8(const bf16_t* p, f32x4& v0, f32x4& v1) { const u32x4 w = *(const u32x4*)p; v0 = (f32x4){bflo(w.x), bfhi(w.x), bflo(w.y), bfhi(w.y)}; v1 = (f32x4){bflo(w.z), bfhi(w.z), bflo(w.w), bfhi(w.w)}; }

__device__ __forceinline__ float row_rstd(const unsigned long long* ss, int row) { return 1.0f / sqrtf((float)ss[row] * (1.0f / (16777216.0f * 1024.0f)) + 1e-6f); }
__device__ __forceinline__ float rstd_of(unsigned long long v) { return __builtin_amdgcn_rsqf((float)v * (1.0f / (16777216.0f * 1024.0f)) + 1e-6f); }
struct EpiProj { static constexpr bool PERM = true, AFTER_DRAIN = false, HAS_MID = false;
    bf16_t *Q, *Kp, *Vp, *U; float qscale; const unsigned long long* ss; int pn0;
    __device__ __forceinline__ void operator()(const f32x4 (&acc)[2][2][4][2], const Unit& u, int wr, int wc, int fr, int fq) const {
        const int row0 = u.pm * BM + wr * 64 + fr; const int pn = u.pn + pn0;
        bf16_t* base; int ldc, colt; float sc = 1.f;
        if (pn < 6) { base = Q; ldc = 1536; colt = pn * 256; sc = qscale; } else if (pn < 12) { base = Kp; ldc = 1536; colt = (pn - 6) * 256; }
        else if (pn < 18) { base = Vp; ldc = 1536; colt = (pn - 12) * 256; } else { base = U; ldc = 512; colt = (pn - 18) * 256; }
        const int col0 = colt + wc * 32 + 8 * fq;
        unsigned long long sv[2][4];
#pragma unroll
        for (int ai = 0; ai < 2; ++ai)
#pragma unroll
            for (int m = 0; m < 4; ++m) sv[ai][m] = ss[row0 + ai * HALF + m * 16];
#pragma unroll
        for (int ai = 0; ai < 2; ++ai)
#pragma unroll
            for (int m = 0; m < 4; ++m) { const int row = row0 + ai * HALF + m * 16; bf16_t* rowp = base + (size_t)row * ldc + col0; const float rs = rstd_of(sv[ai][m]) * sc;
#pragma unroll
                for (int bj = 0; bj < 2; ++bj) st8(rowp + bj * HALF, acc[ai][bj][m][0] * rs, acc[ai][bj][m][1] * rs); }
    }
};
struct EpiSig { static constexpr bool PERM = true, AFTER_DRAIN = false, HAS_MID = false;
    bf16_t* O; int ldc; const unsigned long long* ss;
    __device__ __forceinline__ void operator()(const f32x4 (&acc)[2][2][4][2], const Unit& u, int wr, int wc, int fr, int fq) const {
        const int row0 = u.pm * BM + wr * 64 + fr, col0 = u.pn * BM + wc * 32 + 8 * fq;
        unsigned long long sv[2][4];
#pragma unroll
        for (int ai = 0; ai < 2; ++ai)
#pragma unroll
            for (int m = 0; m < 4; ++m) sv[ai][m] = ss[row0 + ai * HALF + m * 16];
#pragma unroll
        for (int ai = 0; ai < 2; ++ai)
#pragma unroll
            for (int m = 0; m < 4; ++m) { const int row = row0 + ai * HALF + m * 16; bf16_t* rowp = O + (size_t)row * ldc + col0; const float rs = rstd_of(sv[ai][m]);
#pragma unroll
                for (int bj = 0; bj < 2; ++bj) { f32x4 v0 = acc[ai][bj][m][0], v1 = acc[ai][bj][m][1];
#pragma unroll
                    for (int k = 0; k < 4; ++k) { v0[k] = sigm(v0[k] * rs); v1[k] = sigm(v1[k] * rs); }
                    st8(rowp + bj * HALF, v0, v1); } }
    }
};
struct EpiPlain { static constexpr bool PERM = true, AFTER_DRAIN = false, HAS_MID = false;
    bf16_t* O; int ldc;
    __device__ __forceinline__ void operator()(const f32x4 (&acc)[2][2][4][2], const Unit& u, int wr, int wc, int fr, int fq) const {
        asm volatile("" : "+v"(fr), "+v"(fq));
        const int row0 = u.pm * BM + wr * 64 + fr, col0 = u.pn * BM + wc * 32 + 8 * fq;
#pragma unroll
        for (int ai = 0; ai < 2; ++ai)
#pragma unroll
            for (int m = 0; m < 4; ++m) { bf16_t* rowp = O + (size_t)(row0 + ai * HALF + m * 16) * ldc + col0;
#pragma unroll
                for (int bj = 0; bj < 2; ++bj) st8(rowp + bj * HALF, acc[ai][bj][m][0], acc[ai][bj][m][1]); }
    }
};

struct EpiProbe { static constexpr bool PERM = true, AFTER_DRAIN = false, HAS_MID = false;
    bf16_t* O; int ldc; int live;
    __device__ __forceinline__ void operator()(const f32x4 (&acc)[2][2][4][2], const Unit& u, int wr, int wc, int fr, int fq) const {
        asm volatile("" : "+v"(fr), "+v"(fq));
        if (!live) { if (acc[0][0][0][0][0] == 1.2345e-30f && acc[1][1][3][1][3] == 3.3e-31f) O[0] = 0; return; }
        if (live == 4) {
            const int row0 = (int)blockIdx.x * BM + wr * 64 + fr, col0 = wc * 32 + 8 * fq;
#pragma unroll
            for (int ai = 0; ai < 2; ++ai)
#pragma unroll
                for (int m = 0; m < 4; ++m) { bf16_t* rowp = O + (size_t)(row0 + ai * HALF + m * 16) * 256 + col0;
#pragma unroll
                    for (int bj = 0; bj < 2; ++bj) st8(rowp + bj * HALF, acc[ai][bj][m][0], acc[ai][bj][m][1]); }
            return; }
        if (live >= 2) {
            const int lane = fq * 16 + fr, rsh = live == 2 ? 3 : 2, nr = 1 << rsh;
#pragma unroll
            for (int ai = 0; ai < 2; ++ai)
#pragma unroll
                for (int m = 0; m < 4; ++m)
#pragma unroll
                    for (int bj = 0; bj < 2; ++bj) { const int row = u.pm * BM + wr * 64 + ai * HALF + m * 16 + (live == 2 ? bj * 8 : bj * 4) + (lane & (nr - 1));
                        st8(O + (size_t)row * ldc + u.pn * BM + wc * 64 + (lane >> rsh) * 8, acc[ai][bj][m][0], acc[ai][bj][m][1]); }
            return; }
        const int row0 = u.pm * BM + wr * 64 + fr, col0 = u.pn * BM + wc * 32 + 8 * fq;
#pragma unroll
        for (int ai = 0; ai < 2; ++ai)
#pragma unroll
            for (int m = 0; m < 4; ++m) { bf16_t* rowp = O + (size_t)(row0 + ai * HALF + m * 16) * ldc + col0;
#pragma unroll
                for (int bj = 0; bj < 2; ++bj) st8(rowp + bj * HALF, acc[ai][bj][m][0], acc[ai][bj][m][1]); }
    }
};
struct EpiGlu { static constexpr bool PERM = true, AFTER_DRAIN = false, HAS_MID = false;
    const bf16_t* Zin; bf16_t* O; int ldc, ldo; const float* bias;
    __device__ __forceinline__ void operator()(const f32x4 (&acc)[2][2][4][2], const Unit& u, int wr, int wc, int fr, int fq) const {
        const int row0 = u.pm * BM + wr * 64 + fr, col0 = u.pn * BM + wc * 32 + 8 * fq;
        f32x4 bv[2][2];
#pragma unroll
        for (int bj = 0; bj < 2; ++bj)
#pragma unroll
            for (int n = 0; n < 2; ++n) bv[bj][n] = *(const f32x4*)(bias + col0 + bj * HALF + 4 * n);
#pragma unroll
        for (int ai = 0; ai < 2; ++ai) { u32x4 zw[4][2];
#pragma unroll
            for (int m = 0; m < 4; ++m)
#pragma unroll
                for (int bj = 0; bj < 2; ++bj) zw[m][bj] = *(const u32x4*)(Zin + (size_t)(row0 + ai * HALF + m * 16) * ldc + col0 + bj * HALF);
#pragma unroll
            for (int m = 0; m < 4; ++m) { const size_t offo = (size_t)(row0 + ai * HALF + m * 16) * ldo + col0;
#pragma unroll
                for (int bj = 0; bj < 2; ++bj) { const u32x4 w = zw[m][bj]; const f32x4 z0 = (f32x4){bflo(w.x), bfhi(w.x), bflo(w.y), bfhi(w.y)}, z1 = (f32x4){bflo(w.z), bfhi(w.z), bflo(w.w), bfhi(w.w)};
                    f32x4 v0 = acc[ai][bj][m][0] + bv[bj][0], v1 = acc[ai][bj][m][1] + bv[bj][1];
#pragma unroll
                    for (int k = 0; k < 4; ++k) { v0[k] = z0[k] * sigm(v0[k]); v1[k] = z1[k] * sigm(v1[k]); }
                    st8(O + offo + bj * HALF, v0, v1); } } }
    }
};
template <int MODE> struct EpiGate { static constexpr bool PERM = true, AFTER_DRAIN = false, HAS_MID = false;
    const bf16_t* G; int ldg, gcol0; bf16_t* O; int ldc;
    __device__ __forceinline__ void operator()(const f32x4 (&acc)[2][2][4][2], const Unit& u, int wr, int wc, int fr, int fq) const {
        const int row0 = u.pm * BM + wr * 64 + fr, col0 = u.pn * BM + wc * 32 + 8 * fq;
#pragma unroll
        for (int ai = 0; ai < 2; ++ai)
#pragma unroll
            for (int m = 0; m < 4; ++m) { const int row = row0 + ai * HALF + m * 16; const bf16_t* gp = G + (size_t)row * ldg + gcol0 + col0; bf16_t* op = O + (size_t)row * ldc + col0;
#pragma unroll
                for (int bj = 0; bj < 2; ++bj) { f32x4 g0, g1; ld8(gp + bj * HALF, g0, g1);
                    f32x4 v0 = acc[ai][bj][m][0] * g0, v1 = acc[ai][bj][m][1] * g1;
                    if (MODE == 1) { f32x4 p0, p1; ld8(op + bj * HALF, p0, p1); v0 = v0 + p0; v1 = v1 + p1; }
                    st8(op + bj * HALF, v0, v1); } }
    }
};
struct EpiResid { static constexpr bool PERM = false, AFTER_DRAIN = false, HAS_MID = false;
    const float* base; float* out; int ldc;
    __device__ __forceinline__ void operator()(const f32x4 (&acc)[2][2][4][2], const Unit& u, int wr, int wc, int fr, int fq) const {
        const int row0 = u.pm * BM + wr * 64 + fr, col0 = u.pn * BM + wc * 32 + 4 * fq;
#pragma unroll
        for (int ai = 0; ai < 2; ++ai) { f32x4 bv[4][2][2];
#pragma unroll
            for (int m = 0; m < 4; ++m)
#pragma unroll
                for (int bj = 0; bj < 2; ++bj)
#pragma unroll
                    for (int n = 0; n < 2; ++n) bv[m][bj][n] = *(const f32x4*)(base + (size_t)(row0 + ai * HALF + m * 16) * ldc + col0 + bj * HALF + n * 16);
#pragma unroll
            for (int m = 0; m < 4; ++m) { const size_t off = (size_t)(row0 + ai * HALF + m * 16) * ldc + col0;
#pragma unroll
                for (int bj = 0; bj < 2; ++bj)
#pragma unroll
                    for (int n = 0; n < 2; ++n) *(f32x4*)(out + off + bj * HALF + n * 16) = bv[m][bj][n] + acc[ai][bj][m][n]; } }
    }
};
template <bool NORM> struct EpiResidB { static constexpr bool PERM = true, AFTER_DRAIN = false, HAS_MID = false;
    const bf16_t* Xi; int ldi; bf16_t* X; int ldc; unsigned long long* ss; unsigned char* X8;
    __device__ __forceinline__ void operator()(const f32x4 (&acc)[2][2][4][2], const Unit& u, int wr, int wc, int fr, int fq) const {
        asm volatile("" : "+v"(fr), "+v"(fq));
        const int row0 = u.pm * BM + wr * 64 + fr, col0 = u.pn * BM + wc * 32 + 8 * fq;
        u32x4 xw[2][4][2];
#pragma unroll
        for (int ai = 0; ai < 2; ++ai)
#pragma unroll
            for (int m = 0; m < 4; ++m)
#pragma unroll
                for (int bj = 0; bj < 2; ++bj) xw[ai][m][bj] = *(const u32x4*)(Xi + (size_t)(row0 + ai * HALF + m * 16) * ldi + col0 + bj * HALF);
#pragma unroll
        for (int ai = 0; ai < 2; ++ai)
#pragma unroll
            for (int m = 0; m < 4; ++m) { const int row = row0 + ai * HALF + m * 16; bf16_t* op = X + (size_t)row * ldc + col0; float sq = 0.f;
#pragma unroll
                for (int bj = 0; bj < 2; ++bj) { const u32x4 w = xw[ai][m][bj];
                    const f32x4 v0 = (f32x4){bflo(w.x), bfhi(w.x), bflo(w.y), bfhi(w.y)} + acc[ai][bj][m][0], v1 = (f32x4){bflo(w.z), bfhi(w.z), bflo(w.w), bfhi(w.w)} + acc[ai][bj][m][1];
                    st8(op + bj * HALF, v0, v1);
                    if (X8) { typedef unsigned u32x2r __attribute__((ext_vector_type(2))); u32x2r w8; w8.x = pk4_fp8(v0[0] * 4.0f, v0[1] * 4.0f, v0[2] * 4.0f, v0[3] * 4.0f); w8.y = pk4_fp8(v1[0] * 4.0f, v1[1] * 4.0f, v1[2] * 4.0f, v1[3] * 4.0f);
                        *(u32x2r*)(X8 + (size_t)row * 1024 + col0 + bj * HALF) = w8; }
                    if (NORM) sq += ((v0[0] * v0[0] + v0[1] * v0[1]) + (v0[2] * v0[2] + v0[3] * v0[3])) + ((v1[0] * v1[0] + v1[1] * v1[1]) + (v1[2] * v1[2] + v1[3] * v1[3])); }
                if (NORM) { sq += __shfl_xor(sq, 16); sq += __shfl_xor(sq, 32);
                    if (fq == 0) __hip_atomic_fetch_add(ss + row, (unsigned long long)(sq * 16777216.0f), __ATOMIC_RELAXED, __HIP_MEMORY_SCOPE_AGENT); } }
    }
};
struct EpiSwiGlu { static constexpr bool PERM = true, AFTER_DRAIN = false, HAS_MID = false;
    bf16_t* H; int ldc; const unsigned long long* ss;
    __device__ __forceinline__ void operator()(const f32x4 (&acc)[2][2][4][2], const Unit& u, int wr, int wc, int fr, int fq) const {
        const int row0 = u.pm * BM + wr * 64 + fr, col0 = u.pn * HALF + wc * 32 + 8 * fq;
        unsigned long long sv[2][4];
#pragma unroll
        for (int ai = 0; ai < 2; ++ai)
#pragma unroll
            for (int m = 0; m < 4; ++m) sv[ai][m] = ss[row0 + ai * HALF + m * 16];
#pragma unroll
        for (int ai = 0; ai < 2; ++ai)
#pragma unroll
            for (int m = 0; m < 4; ++m) { const int row = row0 + ai * HALF + m * 16; const float rs = rstd_of(sv[ai][m]);
                f32x4 v0 = acc[ai][0][m][0] * rs, v1 = acc[ai][0][m][1] * rs; const f32x4 u0 = acc[ai][1][m][0] * rs, u1 = acc[ai][1][m][1] * rs;
#pragma unroll
                for (int k = 0; k < 4; ++k) { v0[k] = v0[k] * sigm(v0[k]) * u0[k]; v1[k] = v1[k] * sigm(v1[k]) * u1[k]; }
                st8(H + (size_t)row * ldc + col0, v0, v1); }
    }
};

struct EpiGateMid { static constexpr bool PERM = true, AFTER_DRAIN = false, HAS_MID = true;
    const bf16_t* G; int ldg, gs0; bf16_t* O; int ldc;
    __device__ __forceinline__ void mid(f32x4 (&acc)[2][2][4][2], const Unit& u, int wr, int wc, int fr, int fq) const {
        asm volatile("" : "+v"(fr), "+v"(fq));
        const int row0 = u.pm * BM + wr * 64 + fr, col0 = u.pn * BM + wc * 32 + 8 * fq;
#pragma unroll
        for (int ai = 0; ai < 2; ++ai)
#pragma unroll
            for (int mp = 0; mp < 2; ++mp) {
                u32x4 ga[2][2], gs[2][2];
#pragma unroll
                for (int mm = 0; mm < 2; ++mm)
#pragma unroll
                    for (int bj = 0; bj < 2; ++bj) { const bf16_t* gp = G + (size_t)(row0 + ai * HALF + (2 * mp + mm) * 16) * ldg + col0 + bj * HALF; ga[mm][bj] = *(const u32x4*)gp; gs[mm][bj] = *(const u32x4*)(gp + gs0); }
#pragma unroll
                for (int mm = 0; mm < 2; ++mm)
#pragma unroll
                    for (int bj = 0; bj < 2; ++bj) { const int m = 2 * mp + mm; const u32x4 a = ga[mm][bj], s = gs[mm][bj];
                        const f32x4 a0 = (f32x4){bflo(a.x), bfhi(a.x), bflo(a.y), bfhi(a.y)}, a1 = (f32x4){bflo(a.z), bfhi(a.z), bflo(a.w), bfhi(a.w)};
                        const f32x4 s0 = (f32x4){bflo(s.x), bfhi(s.x), bflo(s.y), bfhi(s.y)}, s1 = (f32x4){bflo(s.z), bfhi(s.z), bflo(s.w), bfhi(s.w)};
#pragma unroll
                        for (int k = 0; k < 4; ++k) { acc[ai][bj][m][0][k] *= a0[k] * __builtin_amdgcn_rcpf(s0[k]); acc[ai][bj][m][1][k] *= a1[k] * __builtin_amdgcn_rcpf(s1[k]); } }
                asm volatile("" : "+v"(acc[ai][0][2 * mp][0]), "+v"(acc[ai][0][2 * mp][1]), "+v"(acc[ai][1][2 * mp][0]), "+v"(acc[ai][1][2 * mp][1]), "+v"(acc[ai][0][2 * mp + 1][0]), "+v"(acc[ai][0][2 * mp + 1][1]), "+v"(acc[ai][1][2 * mp + 1][0]), "+v"(acc[ai][1][2 * mp + 1][1]) :: "memory"); }
    }
    __device__ __forceinline__ void operator()(const f32x4 (&acc)[2][2][4][2], const Unit& u, int wr, int wc, int fr, int fq) const {
        asm volatile("" : "+v"(fr), "+v"(fq));
        const int row0 = u.pm * BM + wr * 64 + fr, col0 = u.pn * BM + wc * 32 + 8 * fq;
        u32x4 gw[2][4][2];
#pragma unroll
        for (int ai = 0; ai < 2; ++ai)
#pragma unroll
            for (int m = 0; m < 4; ++m)
#pragma unroll
                for (int bj = 0; bj < 2; ++bj) gw[ai][m][bj] = *(const u32x4*)(G + (size_t)(row0 + ai * HALF + m * 16) * ldg + gs0 + col0 + bj * HALF);
#pragma unroll
        for (int ai = 0; ai < 2; ++ai)
#pragma unroll
            for (int m = 0; m < 4; ++m) { bf16_t* op = O + (size_t)(row0 + ai * HALF + m * 16) * ldc + col0;
#pragma unroll
                for (int bj = 0; bj < 2; ++bj) { const u32x4 w = gw[ai][m][bj]; const f32x4 s0 = (f32x4){bflo(w.x), bfhi(w.x), bflo(w.y), bfhi(w.y)}, s1 = (f32x4){bflo(w.z), bfhi(w.z), bflo(w.w), bfhi(w.w)};
                    st8(op + bj * HALF, acc[ai][bj][m][0] * s0, acc[ai][bj][m][1] * s1); } }
    }
};

struct EpiSwiGlu8 { static constexpr bool PERM = true, AFTER_DRAIN = false, HAS_MID = false;
    unsigned char* H; int ldc; float hs, hmax;
    __device__ __forceinline__ void operator()(const f32x4 (&acc)[2][2][4][2], const Unit& u, int wr, int wc, int fr, int fq) const {
        asm volatile("" : "+v"(fr), "+v"(fq));
        const int row0 = u.pm * BM + wr * 64 + fr, col0 = u.pn * HALF + wc * 32 + 8 * fq;
#pragma unroll
        for (int ai = 0; ai < 2; ++ai)
#pragma unroll
            for (int m = 0; m < 4; ++m) { f32x4 v0 = acc[ai][0][m][0], v1 = acc[ai][0][m][1]; const f32x4 u0 = acc[ai][1][m][0], u1 = acc[ai][1][m][1];
#pragma unroll
                for (int k = 0; k < 4; ++k) { v0[k] = fminf(fmaxf(v0[k] * sigm(v0[k]) * u0[k] * hs, -hmax), hmax); v1[k] = fminf(fmaxf(v1[k] * sigm(v1[k]) * u1[k] * hs, -hmax), hmax); }
                typedef unsigned u32x2 __attribute__((ext_vector_type(2)));
                u32x2 w; w.x = pk4_fp8(v0[0], v0[1], v0[2], v0[3]); w.y = pk4_fp8(v1[0], v1[1], v1[2], v1[3]);
                *(u32x2*)(H + (size_t)(row0 + ai * HALF + m * 16) * ldc + col0) = w; }
    }
};

struct EpiResidNorm { static constexpr bool PERM = false, AFTER_DRAIN = false, HAS_MID = false;
    const float* base; float* out; int ldc; bf16_t* Xb; unsigned long long* ss;
    __device__ __forceinline__ void operator()(const f32x4 (&acc)[2][2][4][2], const Unit& u, int wr, int wc, int fr, int fq) const {
        const int row0 = u.pm * BM + wr * 64 + fr, col0 = u.pn * BM + wc * 32 + 4 * fq;
        typedef unsigned u32x2e __attribute__((ext_vector_type(2)));
#pragma unroll
        for (int ai = 0; ai < 2; ++ai) { f32x4 bv[4][2][2];
#pragma unroll
            for (int m = 0; m < 4; ++m)
#pragma unroll
                for (int bj = 0; bj < 2; ++bj)
#pragma unroll
                    for (int n = 0; n < 2; ++n) bv[m][bj][n] = *(const f32x4*)(base + (size_t)(row0 + ai * HALF + m * 16) * ldc + col0 + bj * HALF + n * 16);
#pragma unroll
            for (int m = 0; m < 4; ++m) { const int row = row0 + ai * HALF + m * 16; const size_t off = (size_t)row * ldc + col0; float sq = 0.f;
#pragma unroll
                for (int bj = 0; bj < 2; ++bj)
#pragma unroll
                    for (int n = 0; n < 2; ++n) { const f32x4 x = bv[m][bj][n] + acc[ai][bj][m][n]; *(f32x4*)(out + off + bj * HALF + n * 16) = x;
                        u32x2e w; w.x = cvt_pk_bf16(x[0], x[1]); w.y = cvt_pk_bf16(x[2], x[3]); *(u32x2e*)(Xb + off + bj * HALF + n * 16) = w;
                        sq += (x[0] * x[0] + x[1] * x[1]) + (x[2] * x[2] + x[3] * x[3]); }
                sq += __shfl_xor(sq, 16); sq += __shfl_xor(sq, 32);
                if (fq == 0) __hip_atomic_fetch_add(ss + row, (unsigned long long)(sq * 16777216.0f), __ATOMIC_RELAXED, __HIP_MEMORY_SCOPE_AGENT); } }
    }
};
template <class Epi, class Sched, bool ALIGN_EPI = false, bool SP2 = false, bool FP8 = false>
__device__ __forceinline__ void gemm_phase(PG8_LAS unsigned char* lds, const Gemm g, const Sched& S, const Epi& E) {
    int tid_ = threadIdx.x; asm volatile("" : "+v"(tid_));
    const int tid = tid_, wid = __builtin_amdgcn_readfirstlane(tid >> 6), lane = tid & 63, wr = wid >> 2, wc = wid & 3, fr = lane & 15, fq = lane >> 4;
    const int K = g.K, nt = K / BK;
    int sw_v = g.sw, sa_v = g.sa; asm volatile("" : "+v"(sw_v), "+v"(sa_v));
    unsigned voffA[2], voffB[2];
#pragma unroll
    for (int i = 0; i < 2; ++i) { int R, C; stage_rc(tid * 16 + i * 8192, R, C); const int Rb = Epi::PERM ? ((R & ~31) + perm32(R & 31)) : R;
        voffA[i] = (unsigned)(R * K + C) * 2u; voffB[i] = (unsigned)(Rb * K + C) * 2u; }
    const size_t kstep = (size_t)(BK * 2);
    const size_t hstep = (size_t)HALF * K * 2;
    const size_t tstep = 2 * hstep;
    const unsigned ldsw = (unsigned)wid * 1024u;
    const int aoff = lds_byte(wr * 64 + fr, fq * 8), boff = lds_byte(wc * 32 + fr, fq * 8);
#define PG8_SA(b, h) (((b) * 2 + (h)) * HTB)
#define PG8_SB(b, h) ((4 + (b) * 2 + (h)) * HTB)
#define PG8_STAGE(bufoff, gbase, voff) do { _Pragma("unroll") for (int _i = 0; _i < 2; ++_i) \
        __builtin_amdgcn_global_load_lds((const unsigned*)((const char*)(gbase) + (voff)[_i]), (PG8_LAS unsigned*)(lds + (bufoff) + ldsw + _i * 8192), 16, 0, 0); } while (0)
#define PG8_LDA(dst, b, h) do { if constexpr (FP8) { _Pragma("unroll") for (int m = 0; m < 4; ++m) dst##8[m] = pg8_cat(*(const PG8_LAS bf16x8*)(lds + PG8_SA(b, h) + aoff + m * 2048), *(const PG8_LAS bf16x8*)(lds + PG8_SA(b, h) + aoff + m * 2048 + 1024)); } else { \
        _Pragma("unroll") for (int m = 0; m < 4; ++m) _Pragma("unroll") for (int k = 0; k < 2; ++k) dst[m][k] = *(const PG8_LAS bf16x8*)(lds + PG8_SA(b, h) + aoff + m * 2048 + k * 1024); } } while (0)
#define PG8_LDB(dst, b, h) do { if constexpr (FP8) { _Pragma("unroll") for (int n = 0; n < 2; ++n) dst##8[n] = pg8_cat(*(const PG8_LAS bf16x8*)(lds + PG8_SB(b, h) + boff + n * 2048), *(const PG8_LAS bf16x8*)(lds + PG8_SB(b, h) + boff + n * 2048 + 1024)); } else { \
        _Pragma("unroll") for (int n = 0; n < 2; ++n) _Pragma("unroll") for (int k = 0; k < 2; ++k) dst[n][k] = *(const PG8_LAS bf16x8*)(lds + PG8_SB(b, h) + boff + n * 2048 + k * 1024); } } while (0)
#define PG8_MMA(ai, bj, At, Bt) do { __builtin_amdgcn_s_setprio(1); if constexpr (FP8) { _Pragma("unroll") for (int m = 0; m < 4; ++m) _Pragma("unroll") for (int n = 0; n < 2; ++n) \
        asm volatile("v_mfma_scale_f32_16x16x128_f8f6f4 %0, %1, %2, %0, %3, %4 op_sel_hi:[0,0,0]" : "+v"(acc[ai][bj][m][n]) : "v"(Bt##8[n]), "v"(At##8[m]), "v"(sw_v), "v"(sa_v)); } else { \
        _Pragma("unroll") for (int m = 0; m < 4; ++m) _Pragma("unroll") for (int n = 0; n < 2; ++n) _Pragma("unroll") for (int k = 0; k < 2; ++k) \
        acc[ai][bj][m][n] = __builtin_amdgcn_mfma_f32_16x16x32_bf16(Bt[n][k], At[m][k], acc[ai][bj][m][n], 0, 0, 0); } __builtin_amdgcn_s_setprio(0); } while (0)
#define PG8_WAIT_V(n) asm volatile("s_waitcnt vmcnt(" #n ")" ::: "memory")
#define PG8_WAIT_L(n) asm volatile("s_waitcnt lgkmcnt(" #n ")" ::: "memory")
#define PG8_BAR __builtin_amdgcn_s_barrier()
#define PG8_SCHED __builtin_amdgcn_sched_barrier(0)
    Unit cur, nxt; int ui = 0;
    if (!S.next(0, cur)) return;
    f32x4 acc[2][2][4][2];
#pragma unroll
    for (int a = 0; a < 2; ++a)
#pragma unroll
        for (int b = 0; b < 2; ++b)
#pragma unroll
            for (int m = 0; m < 4; ++m)
#pragma unroll
                for (int n = 0; n < 2; ++n) acc[a][b][m][n] = (f32x4){0.f, 0.f, 0.f, 0.f};
    bf16x8 At[4][2], B0[2][2], B1[2][2];
    pg8_v8i At8[4], B08[2], B18[2];
    const char* cA = (const char*)g.A + (size_t)cur.pm * tstep; const char* cB = (const char*)g.Bt + cur.boff + (size_t)cur.pn * tstep;
    S.a_ready(cur);
    if constexpr (SP2) {
        PG8_STAGE(PG8_SB(0, 0), cB, voffB); PG8_STAGE(PG8_SB(0, 1), cB + hstep, voffB); PG8_STAGE(PG8_SA(0, 0), cA, voffA); PG8_STAGE(PG8_SA(0, 1), cA + hstep, voffA);
        if (wr == 1) PG8_BAR;
        PG8_WAIT_V(2); PG8_BAR;
        PG8_STAGE(PG8_SB(1, 0), cB + kstep, voffB); PG8_STAGE(PG8_SA(1, 0), cA + kstep, voffA); PG8_STAGE(PG8_SB(1, 1), cB + hstep + kstep, voffB);
        PG8_WAIT_V(6); PG8_BAR;
    } else {
        PG8_STAGE(PG8_SB(0, 0), cB, voffB); PG8_STAGE(PG8_SA(0, 0), cA, voffA); PG8_STAGE(PG8_SB(0, 1), cB + hstep, voffB); PG8_STAGE(PG8_SA(0, 1), cA + hstep, voffA);
        if (wr == 1) PG8_BAR;
        PG8_WAIT_V(4); PG8_BAR;
        PG8_STAGE(PG8_SB(1, 0), cB + kstep, voffB); PG8_STAGE(PG8_SA(1, 0), cA + kstep, voffA); PG8_STAGE(PG8_SB(1, 1), cB + hstep + kstep, voffB);
        PG8_WAIT_V(6); PG8_BAR;
    }
    for (;;) {
        const bool has_next = S.next(ui + 1, nxt);
        const char* nA = has_next ? (const char*)g.A + (size_t)nxt.pm * tstep : cA; const char* nB = has_next ? (const char*)g.Bt + nxt.boff + (size_t)nxt.pn * tstep : cB;
        _Pragma("nounroll")
        for (int t = 0; t < nt; t += 2) {
            if constexpr (Epi::HAS_MID) { if (t == nt / 2) E.mid(acc, cur, wr, wc, fr, fq); }
            const bool last = (t == nt - 2);
            const char* a1 = cA + (size_t)(t + 1) * kstep;
            const char* a2 = last ? nA : cA + (size_t)(t + 2) * kstep; const char* b2 = last ? nB : cB + (size_t)(t + 2) * kstep;
            const char* a3 = a2 + kstep; const char* b3 = b2 + kstep;
            if (last && has_next) S.a_ready(nxt);
            if constexpr (SP2) {
            PG8_LDB(B0, 0, 0); PG8_LDB(B1, 0, 1); PG8_SCHED; PG8_LDA(At, 0, 0); PG8_STAGE(PG8_SA(1, 1), a1 + hstep, voffA);
            PG8_WAIT_V(8); PG8_WAIT_L(0); PG8_BAR; PG8_MMA(0, 0, At, B0); PG8_MMA(0, 1, At, B1); PG8_BAR; PG8_SCHED;
            PG8_LDA(At, 0, 1); PG8_STAGE(PG8_SB(0, 0), b2, voffB); PG8_STAGE(PG8_SB(0, 1), b2 + hstep, voffB); PG8_STAGE(PG8_SA(0, 0), a2, voffA);
            PG8_WAIT_V(8); PG8_WAIT_L(0); PG8_BAR; PG8_MMA(1, 0, At, B0); PG8_MMA(1, 1, At, B1); PG8_BAR; PG8_SCHED;
            PG8_LDB(B0, 1, 0); PG8_LDB(B1, 1, 1); PG8_SCHED; PG8_LDA(At, 1, 0); PG8_STAGE(PG8_SA(0, 1), a2 + hstep, voffA);
            PG8_WAIT_V(8); PG8_WAIT_L(0); PG8_BAR; PG8_MMA(0, 0, At, B0); PG8_MMA(0, 1, At, B1); PG8_BAR; PG8_SCHED;
            PG8_LDA(At, 1, 1); PG8_STAGE(PG8_SB(1, 0), b3, voffB); PG8_STAGE(PG8_SB(1, 1), b3 + hstep, voffB); PG8_STAGE(PG8_SA(1, 0), a3, voffA);
            PG8_WAIT_V(8); PG8_WAIT_L(0); PG8_BAR; PG8_MMA(1, 0, At, B0); PG8_MMA(1, 1, At, B1); PG8_BAR; PG8_SCHED;
            } else {
            PG8_LDB(B0, 0, 0); PG8_SCHED; PG8_LDA(At, 0, 0); PG8_STAGE(PG8_SA(1, 1), a1 + hstep, voffA);
            PG8_WAIT_L(8); PG8_BAR; PG8_WAIT_L(0); PG8_MMA(0, 0, At, B0); PG8_BAR; PG8_SCHED;
            PG8_LDB(B1, 0, 1); PG8_STAGE(PG8_SB(0, 0), b2, voffB);
            PG8_BAR; PG8_WAIT_L(0); PG8_MMA(0, 1, At, B1); PG8_BAR;
            PG8_LDA(At, 0, 1); PG8_STAGE(PG8_SA(0, 0), a2, voffA);
            PG8_BAR; PG8_WAIT_L(0); PG8_MMA(1, 0, At, B0); PG8_BAR; PG8_SCHED;
            PG8_STAGE(PG8_SB(0, 1), b2 + hstep, voffB);
            PG8_WAIT_V(6); PG8_BAR; PG8_MMA(1, 1, At, B1); PG8_BAR;
            PG8_LDB(B0, 1, 0); PG8_SCHED; PG8_LDA(At, 1, 0); PG8_STAGE(PG8_SA(0, 1), a2 + hstep, voffA);
            PG8_WAIT_L(8); PG8_BAR; PG8_WAIT_L(0); PG8_MMA(0, 0, At, B0); PG8_BAR; PG8_SCHED;
            PG8_LDB(B1, 1, 1); PG8_STAGE(PG8_SB(1, 0), b3, voffB);
            PG8_BAR; PG8_WAIT_L(0); PG8_MMA(0, 1, At, B1); PG8_BAR;
            PG8_LDA(At, 1, 1); PG8_STAGE(PG8_SA(1, 0), a3, voffA);
            PG8_BAR; PG8_WAIT_L(0); PG8_MMA(1, 0, At, B0); PG8_BAR; PG8_SCHED;
            PG8_STAGE(PG8_SB(1, 1), b3 + hstep, voffB);
            PG8_WAIT_V(6); PG8_BAR; PG8_MMA(1, 1, At, B1); PG8_BAR;
            }
        }
        if constexpr (FP8) {
            _Pragma("unroll") for (int a_ = 0; a_ < 2; ++a_) _Pragma("unroll") for (int b_ = 0; b_ < 2; ++b_) asm volatile("s_nop 15" : "+v"(acc[a_][b_][0][0]), "+v"(acc[a_][b_][0][1]), "+v"(acc[a_][b_][1][0]), "+v"(acc[a_][b_][1][1]), "+v"(acc[a_][b_][2][0]), "+v"(acc[a_][b_][2][1]), "+v"(acc[a_][b_][3][0]), "+v"(acc[a_][b_][3][1])); }
        if constexpr (ALIGN_EPI) { if (wr == 0) PG8_BAR; }
        if constexpr (!Epi::AFTER_DRAIN) { E(acc, cur, wr, wc, fr, fq); S.done(cur); }
        if (!has_next) break;
#pragma unroll
        for (int a = 0; a < 2; ++a)
#pragma unroll
            for (int b = 0; b < 2; ++b)
#pragma unroll
                for (int m = 0; m < 4; ++m)
#pragma unroll
                    for (int n = 0; n < 2; ++n) acc[a][b][m][n] = (f32x4){0.f, 0.f, 0.f, 0.f};
        cur = nxt; cA = nA; cB = nB; ++ui;
        if constexpr (ALIGN_EPI) { if (wr == 1) PG8_BAR; }
    }
    PG8_WAIT_V(0);
    if constexpr (!ALIGN_EPI) { if (wr == 0) PG8_BAR; }
    PG8_BAR;
    if constexpr (Epi::AFTER_DRAIN) { E.fused(acc, cur, wr, wc, fr, fq, lds, wid, lane); S.done(cur); }
#undef PG8_SA
#undef PG8_SB
#undef PG8_STAGE
#undef PG8_LDA
#undef PG8_LDB
#undef PG8_MMA
#undef PG8_WAIT_V
#undef PG8_WAIT_L
#undef PG8_BAR
#undef PG8_SCHED
}
}

#define GAS __attribute__((address_space(1)))
#define LAS __attribute__((address_space(3)))
typedef unsigned short bf16;
typedef unsigned v4u __attribute__((ext_vector_type(4)));
typedef float f32x4 __attribute__((ext_vector_type(4)));
typedef short bf16x8 __attribute__((ext_vector_type(8)));
typedef GAS unsigned gu32;
typedef GAS unsigned long long gu64;
#define RLX_AGENT __ATOMIC_RELAXED, __HIP_MEMORY_SCOPE_AGENT
#define LDS_WAIT() asm volatile("s_waitcnt lgkmcnt(0)" ::: "memory")
#define VM_WAIT() asm volatile("s_waitcnt vmcnt(0)" ::: "memory")
__device__ __forceinline__ unsigned long long rt() { return __builtin_amdgcn_s_memrealtime(); }
__device__ __forceinline__ unsigned f2bf(float f) { unsigned u = __builtin_bit_cast(unsigned, f); return (u + 0x7fffu + ((u >> 16) & 1u)) >> 16; }
__device__ __forceinline__ unsigned pk2(float lo, float hi) { return f2bf(lo) | (f2bf(hi) << 16); }

#define XB_TMO      128
#define XB_XCNT(j)  (256  + 64 * (j))
#define XB_XSUB(j)  (1280 + 64 * (j))
#define XB_XGEN(j)  (2304 + 64 * (j))
#define XB_TOP      3328
#define XB_TOPGEN   3392
#define XCD_BAR_WORDS 3456
#define XB_SPIN_CAP (1u << 18)

__device__ __forceinline__ unsigned xb_ld(unsigned* p)              { return __hip_atomic_load(p, __ATOMIC_RELAXED, __HIP_MEMORY_SCOPE_AGENT); }
__device__ __forceinline__ unsigned xb_add(unsigned* p, unsigned v) { return __hip_atomic_fetch_add(p, v, __ATOMIC_RELAXED, __HIP_MEMORY_SCOPE_AGENT); }
__device__ __forceinline__ unsigned xb_xcc_id() { return (unsigned)__builtin_amdgcn_s_getreg((3 << 11) | 20) & 0xFu; }
#define XB_SPIN(cond, bar) do { unsigned _sp = 0; while (cond) { __builtin_amdgcn_s_sleep(1); \
    if ((++_sp & 255u) == 0u) { if (xb_ld(&(bar)[XB_TMO])) break; if (_sp > XB_SPIN_CAP) { atomicAdd(&(bar)[XB_TMO], 1u); break; } } } } while (0)

struct XcdBarrier {
    unsigned* bar; unsigned x;
    volatile LAS unsigned* st;
};

__device__ __forceinline__ XcdBarrier xcd_barrier_post(unsigned* bar, volatile LAS unsigned* st) {
    XcdBarrier b; b.bar = bar; b.x = xb_xcc_id(); b.st = st;
    if (threadIdx.x == 0) (void)xb_add(&bar[XB_XCNT(b.x)], 1u);
    return b;
}
__device__ __forceinline__ void xcd_barrier_complete(unsigned* bar, unsigned x, unsigned& nloc, unsigned& nx) {
    const unsigned G = gridDim.x * gridDim.y * gridDim.z;
    unsigned sum, cnt, mine, sp = 0u;
    for (;;) {
        sum = 0u; cnt = 0u; mine = 0u;
#pragma unroll
        for (unsigned j = 0; j < 16; ++j) { const unsigned c = xb_ld(&bar[XB_XCNT(j)]); sum += c; cnt += (c > 0u) ? 1u : 0u; mine = (j == x) ? c : mine; }
        if (sum == G) break;
        __builtin_amdgcn_s_sleep(1);
        if ((++sp & 255u) == 0u) { if (xb_ld(&bar[XB_TMO])) break; if (sp > XB_SPIN_CAP) { atomicAdd(&bar[XB_TMO], 1u); break; } }
    }
    nloc = mine > 0u ? mine : 1u; nx = cnt > 0u ? cnt : 1u;
}

__device__ __forceinline__ void xcd_barrier(const XcdBarrier& b) {
    asm volatile("s_waitcnt vmcnt(0)" ::: "memory");
    __syncthreads();
    if (threadIdx.x == 0) {
        unsigned* bar = b.bar;
        __builtin_amdgcn_s_waitcnt(0);
        unsigned nloc = b.st[0], nx = b.st[1];
        if (nloc == 0u) { xcd_barrier_complete(bar, b.x, nloc, nx); b.st[0] = nloc; b.st[1] = nx; }
        const unsigned old = xb_add(&bar[XB_XSUB(b.x)], 1u);
        const unsigned gen = old / nloc;
        if (old + 1u == (gen + 1u) * nloc) {
            __builtin_amdgcn_fence(__ATOMIC_RELEASE, "agent");
            asm volatile("s_waitcnt vmcnt(0)" ::: "memory");
            const unsigned og = xb_add(&bar[XB_TOP], 1u);
            const unsigned tg = og / nx;
            if (og + 1u == (tg + 1u) * nx) xb_add(&bar[XB_TOPGEN], 1u);
            else XB_SPIN(xb_ld(&bar[XB_TOPGEN]) == tg, bar);
            __builtin_amdgcn_fence(__ATOMIC_ACQUIRE, "agent");
            xb_add(&bar[XB_XGEN(b.x)], 1u);
            asm volatile("s_waitcnt vmcnt(0)" ::: "memory");
        } else {
            XB_SPIN(xb_ld(&bar[XB_XGEN(b.x)]) == gen, bar);
            __builtin_amdgcn_fence(__ATOMIC_ACQUIRE, "agent");
            asm volatile("s_waitcnt vmcnt(0)" ::: "memory");
        }
    }
    __syncthreads();
}

constexpr int NWAVES = 8;
constexpr int DM = 1024, BATCH = 2, SEQ = 16384, NTOK = BATCH * SEQ;
constexpr int AW = 1536, AOUT = 512, SW = 512, PW = 7168, NQKVU = 5120, NGATE = 2048;
constexpr int FF = 2816, FFE = 3584, NEXP = 8;
constexpr int SSM_G = 32, SSM_P = 64, SSM_C = 16, CHUNK = 128, NCHUNK = SEQ / CHUNK;
constexpr float EPS = 1e-6f;
constexpr float LOG2E = 1.4426950408889634f;
constexpr int MOE_ROWS = 2 * NTOK + NEXP * 256;
constexpr int MOE_NCHUNK = 1;
constexpr int N_PHASES = 26;

constexpr size_t MiB = 1u << 20, KiB = 1u << 10;
constexpr size_t WS_CTL = 0, CTL_ZERO_BYTES = 1 * MiB;
constexpr size_t TAB_BIAS = 1 * MiB;
constexpr size_t TAB_LAMB = 1 * MiB + 16 * KiB;
constexpr size_t TAB_BB   = 1 * MiB + 64 * KiB;
constexpr size_t TAB_CM   = 1 * MiB + 576 * KiB;
constexpr size_t TOK_E = 2 * MiB, TOK_R = TOK_E + 128 * KiB, TOK_G = TOK_R + 256 * KiB, TOK_S = TOK_G + 256 * KiB, CNTWG = TOK_S + 256 * KiB;
constexpr size_t WS_LSE = 4 * MiB;
constexpr size_t WS_E = 8 * MiB;
constexpr size_t WS_WS = 12 * MiB, WL_STRIDE = 18 * MiB + 512 * KiB;
constexpr size_t WL_QKVU = 0, WL_G = 10 * MiB, WL_GLU = 14 * MiB, WL_ABR = 14 * MiB + 512 * KiB, WL_SBR = 15 * MiB + 512 * KiB, WL_OUT = 16 * MiB + 512 * KiB;
constexpr size_t WS_W13 = WS_WS + 37 * MiB, WS_W2 = WS_WS + 48 * MiB;
constexpr size_t WS_H = 66 * MiB, WS_QP = 130 * MiB, WS_KP = 226 * MiB, WS_VP = 322 * MiB, WS_U = 418 * MiB, WS_Z = 450 * MiB, WS_AO = 482 * MiB;
constexpr size_t WS_G = WS_KP, WS_M = WS_QP, WS_ZG = WS_U, WS_HID = 130 * MiB;
constexpr size_t WS_MW13 = 12 * MiB, WS_MW2 = 68 * MiB, WS_XS = 96 * MiB, WS_Y = 162 * MiB, WS_HID0 = 294 * MiB, WS_END = 536 * MiB;
static_assert(WS_W2 + (size_t)DM * FF * 2 <= WS_H && WS_AO + (size_t)NTOK * 2 * AOUT * 2 <= 572 * MiB && WS_HID + (size_t)NTOK * FF * 2 <= WS_U, "ws map");
static_assert(WS_MW13 + (size_t)NEXP * 2 * FFE * DM == WS_MW2 && WS_MW2 + (size_t)NEXP * DM * FFE == WS_XS && WS_XS + (size_t)MOE_ROWS * DM == WS_Y && WS_Y + (size_t)MOE_ROWS * DM * 2 == WS_HID0 && WS_HID0 + (size_t)MOE_ROWS * FFE <= WS_END, "moe ws map");
constexpr float MOE_W13_SCALE = 32.0f, MOE_W2_SCALE = 64.0f, MOE_HID_SCALE = 8.0f, MOE_HID_MAX = 440.0f;
#ifndef QK_FP8
#define QK_FP8 1
#endif
constexpr int NQK = 4608;
constexpr size_t WL_VU_OFF = 5 * MiB;
#ifndef GATE_FP8
#define GATE_FP8 1
#endif
constexpr float X8_SCALE = 4.0f; constexpr int E8_X = 0x7d7d7d7d;
constexpr int E8_W13 = 0x7a7a7a7a, E8_W2 = 0x79797979, E8_HID = 0x7c7c7c7c, E8_ONE = 0x7f7f7f7f;
constexpr int CW_TMO = 0, CW_BAR = 4096;
constexpr size_t SS_P0 = 64 * KiB, SS_A = 320 * KiB, SS_B = 576 * KiB;
constexpr float SS_SCALE = 16777216.0f, SS_INV = 1.0f / (16777216.0f * 1024.0f);

constexpr int RING_BYTES = 131072, LDSCTL_OFF = RING_BYTES, MISC_OFF = LDSCTL_OFF + 320, LDS_BYTES = 147456;

template <class T> __device__ __forceinline__ T* as_global(T* p) { return (T*)(GAS T*)p; }
struct Ctx { LAS unsigned char* lds; int tid, lane, wave, vcu, G; };
typedef float f32x2v __attribute__((ext_vector_type(2)));
typedef int i32x2v __attribute__((ext_vector_type(2)));
typedef short v4i16_t __attribute__((ext_vector_type(4)));
__device__ __forceinline__ float wave_sum(float v) {
#pragma unroll
    for (int o = 1; o < 64; o <<= 1) v += __shfl_xor(v, o);
    return v;
}
__device__ __forceinline__ float bf2f(bf16 h) { return __uint_as_float((unsigned)h << 16); }
__device__ __forceinline__ float sigm_f(float x) { return __builtin_amdgcn_rcpf(1.0f + __builtin_amdgcn_exp2f(-LOG2E * x)); }
__device__ __forceinline__ unsigned cvtpk(float lo, float hi) { return pg8::cvt_pk_bf16(lo, hi); }

__device__ __forceinline__ void build_tables(const Ctx& C, const float* rel_bias, const float* lam_re, const float* lam_im, const float* log_dt,
                                             const float* b_re, const float* b_im, const float* c_re, const float* c_im, unsigned char* ws) {
    const int gt = C.vcu * 512 + C.tid, GT = C.G * 512;
    float* bt = (float*)(ws + TAB_BIAS);
    for (int i = gt; i < 3 * 8 * 129; i += GT) {
        const int g = i / (8 * 129), rem = i % (8 * 129), j = rem / 129, dl = rem % 129;
        const int r = (g == 0) ? 1 : (g == 1 ? 4 : 16), dist = dl * r; int bk;
        if (dist < 16) bk = dist; else { const int v = 16 + (int)(log((double)dist / 16.0) / log(128.0) * 16.0); bk = v < 31 ? v : 31; }
        bt[(g * 8 + j) * 132 + dl] = rel_bias[bk * 24 + g * 8 + j] * LOG2E;
    }
    f32x2v* lamb = (f32x2v*)(ws + TAB_LAMB); bf16* BB = (bf16*)(ws + TAB_BB); bf16* CM = (bf16*)(ws + TAB_CM);
    for (int i = gt; i < 2 * SSM_G * SSM_P; i += GT) {
        const int gi = i >> 6, p = i & 63;
        const double dt = exp((double)log_dt[gi]), lr = (double)lam_re[i], li = (double)lam_im[i];
        const double mag = exp(lr * dt), ang = li * dt, lbx = mag * cos(ang), lby = mag * sin(ang);
        const double nx = lbx - 1.0, ny = lby, den = lr * lr + li * li, qx = (nx * lr + ny * li) / den, qy = (ny * lr - nx * li) / den;
        lamb[i] = (f32x2v){(float)lbx, (float)lby};
        for (int c = 0; c < 16; ++c) { const double br = (double)b_re[(size_t)i * 16 + c], bi = (double)b_im[(size_t)i * 16 + c];
            BB[((size_t)gi * 128 + 2 * p) * 32 + c] = (bf16)f2bf((float)(qx * br - qy * bi)); BB[((size_t)gi * 128 + 2 * p + 1) * 32 + c] = (bf16)f2bf((float)(qx * bi + qy * br));
            BB[((size_t)gi * 128 + 2 * p) * 32 + 16 + c] = 0; BB[((size_t)gi * 128 + 2 * p + 1) * 32 + 16 + c] = 0; }
        for (int c = 0; c < 16; ++c) { CM[((size_t)gi * 16 + c) * 128 + 2 * p] = (bf16)f2bf(c_re[((size_t)gi * 16 + c) * 64 + p]); CM[((size_t)gi * 16 + c) * 128 + 2 * p + 1] = (bf16)f2bf(-c_im[((size_t)gi * 16 + c) * 64 + p]); }
    }
}
template <int MODE>
__device__ __forceinline__ void transpose_item(const float* W, int K, int ldw, int c0, int ncols, bf16* WT, int row0, LAS float* scr, int item, int lane, int ldk = 0, int kofs = 0, const float* gs = nullptr) {
    const int nblk = ncols / 32, kb = item / nblk, nb = item % nblk, k0 = 64 * kb, n0 = 32 * nb;
    float tv[32];
#pragma unroll
    for (int i = 0; i < 32; ++i) tv[i] = W[(size_t)(k0 + 2 * i + (lane >> 5)) * ldw + c0 + n0 + (lane & 31)];
    if (gs) {
#pragma unroll
        for (int i = 0; i < 32; ++i) tv[i] *= gs[k0 + 2 * i + (lane >> 5)]; }
#pragma unroll
    for (int i = 0; i < 32; ++i) scr[(2 * i + (lane >> 5)) * 33 + (lane & 31)] = tv[i];
    LDS_WAIT(); asm volatile("" ::: "memory");
    const int c = lane & 7;
#pragma unroll
    for (int j = 0; j < 4; ++j) { const int n = (lane >> 3) + 8 * j; const LAS float* s = scr + (8 * c) * 33 + n;
        v4u o; o.x = pk2(s[0 * 33], s[1 * 33]); o.y = pk2(s[2 * 33], s[3 * 33]); o.z = pk2(s[4 * 33], s[5 * 33]); o.w = pk2(s[6 * 33], s[7 * 33]);
        const int nn = n0 + n; const int drow = MODE ? row0 + (nn >> 7) * 256 + (nn & 127) : row0 + nn;
        *(GAS v4u*)(WT + (size_t)drow * (ldk ? ldk : K) + kofs + k0 + 8 * c) = o; }
    LDS_WAIT(); asm volatile("" ::: "memory");
}
template <int MODE>
__device__ __forceinline__ void transpose_item8(const float* W, int K, int ldw, int c0, int ncols, unsigned char* WT, int row0, LAS float* scr, int item, int lane, float scale, const float* gs = nullptr) {
    const int nblk = ncols / 32, kb = item / nblk, nb = item % nblk, k0 = 64 * kb, n0 = 32 * nb;
    float tv[32];
#pragma unroll
    for (int i = 0; i < 32; ++i) tv[i] = W[(size_t)(k0 + 2 * i + (lane >> 5)) * ldw + c0 + n0 + (lane & 31)];
    if (gs) {
#pragma unroll
        for (int i = 0; i < 32; ++i) tv[i] *= gs[k0 + 2 * i + (lane >> 5)]; }
#pragma unroll
    for (int i = 0; i < 32; ++i) scr[(2 * i + (lane >> 5)) * 33 + (lane & 31)] = tv[i] * scale;
    LDS_WAIT(); asm volatile("" ::: "memory");
    const int c = lane & 7;
    typedef unsigned u32x2v __attribute__((ext_vector_type(2)));
#pragma unroll
    for (int j = 0; j < 4; ++j) { const int n = (lane >> 3) + 8 * j; const LAS float* s = scr + (8 * c) * 33 + n;
        u32x2v o; o.x = pg8::pk4_fp8(s[0 * 33], s[1 * 33], s[2 * 33], s[3 * 33]); o.y = pg8::pk4_fp8(s[4 * 33], s[5 * 33], s[6 * 33], s[7 * 33]);
        const int nn = n0 + n; const int drow = MODE ? row0 + (nn >> 7) * 256 + (nn & 127) : row0 + nn;
        *(GAS u32x2v*)(WT + (size_t)drow * K + k0 + 8 * c) = o; }
    LDS_WAIT(); asm volatile("" ::: "memory");
}
__device__ __forceinline__ void convert_small_weights(const Ctx& C, const float* const* in, unsigned char* ws) {
    LAS float* scr = (LAS float*)(C.lds + C.wave * 16384);
    const int gw = C.vcu * NWAVES + C.wave, NGW = C.G * NWAVES;
    constexpr int I1 = 16 * 160, I2 = 16 * 64, I3 = 8 * 16, I4 = 8 * 32, I5 = 8 * 32, I6 = 16 * 32, IL = I1 + I2 + I3 + I4 + I5 + I6;
    constexpr int I7 = 16 * 88, I8 = 16 * 88, I9 = 44 * 32, NITEMS = 2 * IL + I7 + I8 + I9;
    for (int it = gw; it < NITEMS; it += NGW) {
        int r = it;
        if (r < 2 * IL) { const int l = r / IL; r -= l * IL; unsigned char* wl = ws + WS_WS + (size_t)l * WL_STRIDE;
#if QK_FP8
            if (r < I1) { constexpr int IQK = 16 * (NQK / 32);
                if (r < IQK) transpose_item8<0>(as_global(in[3]) + (size_t)l * DM * PW, DM, PW, 0, NQK, wl + WL_QKVU, 0, scr, r, C.lane, MOE_W13_SCALE, as_global(in[2]) + (size_t)l * DM);
                else transpose_item<0>(as_global(in[3]) + (size_t)l * DM * PW, DM, PW, NQK, NQKVU - NQK, (bf16*)(wl + WL_QKVU + WL_VU_OFF), 0, scr, r - IQK, C.lane, 0, 0, as_global(in[2]) + (size_t)l * DM);
                continue; } r -= I1;
#else
            if (r < I1) { transpose_item<0>(as_global(in[3]) + (size_t)l * DM * PW, DM, PW, 0, NQKVU, (bf16*)(wl + WL_QKVU), 0, scr, r, C.lane, 0, 0, as_global(in[2]) + (size_t)l * DM); continue; } r -= I1;
#endif
#if GATE_FP8
            if (r < I2) { transpose_item8<0>(as_global(in[3]) + (size_t)l * DM * PW, DM, PW, NQKVU, NGATE, wl + WL_G, 0, scr, r, C.lane, MOE_W13_SCALE, as_global(in[2]) + (size_t)l * DM); continue; } r -= I2;
#else
            if (r < I2) { transpose_item<0>(as_global(in[3]) + (size_t)l * DM * PW, DM, PW, NQKVU, NGATE, (bf16*)(wl + WL_G), 0, scr, r, C.lane, 0, 0, as_global(in[2]) + (size_t)l * DM); continue; } r -= I2;
#endif
            if (r < I3) { transpose_item<0>(as_global(in[12]) + (size_t)l * SW * SW, SW, SW, 0, SW, (bf16*)(wl + WL_GLU), 0, scr, r, C.lane); continue; } r -= I3;
            if (r < I4) { transpose_item<0>(as_global(in[14]) + (size_t)l * AOUT * DM, AOUT, DM, 0, DM, (bf16*)(wl + WL_ABR), 0, scr, r, C.lane, 2 * AOUT, 0); continue; } r -= I4;
            if (r < I5) { transpose_item<0>(as_global(in[15]) + (size_t)l * SW * DM, SW, DM, 0, DM, (bf16*)(wl + WL_ABR), 0, scr, r, C.lane, 2 * AOUT, AOUT); continue; } r -= I5;
            transpose_item<0>(as_global(in[16]) + (size_t)l * DM * DM, DM, DM, 0, DM, (bf16*)(wl + WL_OUT), 0, scr, r, C.lane); continue; }
        r -= 2 * IL;
        if (r < I7) { transpose_item<1>(as_global(in[18]), DM, FF, 0, FF, (bf16*)(ws + WS_W13), 0, scr, r, C.lane, 0, 0, as_global(in[17])); continue; } r -= I7;
        if (r < I8) { transpose_item<1>(as_global(in[19]), DM, FF, 0, FF, (bf16*)(ws + WS_W13), 128, scr, r, C.lane, 0, 0, as_global(in[17])); continue; } r -= I8;
        transpose_item<0>(as_global(in[20]), FF, DM, 0, DM, (bf16*)(ws + WS_W2), 0, scr, r, C.lane);
    }
}
__device__ __forceinline__ void convert_moe_weights(const Ctx& C, const float* const* in, unsigned char* ws, int nwc) {
    LAS float* scr = (LAS float*)(C.lds + C.wave * 16384);
    const int gw = C.vcu * nwc + C.wave, NGW = C.G * nwc;
    constexpr int IG = 16 * 112, ID = 56 * 32, IE = 2 * IG + ID, NITEMS = NEXP * IE;
    for (int it = gw; it < NITEMS; it += NGW) {
        const int e = it / IE; int r = it - e * IE;
        unsigned char* w13 = ws + WS_MW13 + (size_t)e * 2 * FFE * DM; unsigned char* w2 = ws + WS_MW2 + (size_t)e * DM * FFE;
        if (r < IG) { transpose_item8<1>(as_global(in[22]) + (size_t)e * DM * FFE, DM, FFE, 0, FFE, w13, 0, scr, r, C.lane, MOE_W13_SCALE); continue; } r -= IG;
        if (r < IG) { transpose_item8<1>(as_global(in[23]) + (size_t)e * DM * FFE, DM, FFE, 0, FFE, w13, 128, scr, r, C.lane, MOE_W13_SCALE); continue; } r -= IG;
        transpose_item8<0>(as_global(in[24]) + (size_t)e * FFE * DM, FFE, DM, 0, DM, w2, 0, scr, r, C.lane, MOE_W2_SCALE);
    }
}

__device__ __forceinline__ void prep_rows(const Ctx& C, const float* x, bf16* out, unsigned long long* ss, unsigned char* out8) {
    const int gw = C.vcu * NWAVES + C.wave, NGW = C.G * NWAVES;
    for (int m = gw; m < NTOK; m += 2 * NGW) {
        const int m2 = (m + NGW < NTOK) ? m + NGW : m;
        const GAS f32x4* xr = (const GAS f32x4*)(x + (size_t)m * DM) + C.lane; const GAS f32x4* xr2 = (const GAS f32x4*)(x + (size_t)m2 * DM) + C.lane;
        f32x4 v[4], w[4]; float s = 0.f, s2 = 0.f;
#pragma unroll
        for (int j = 0; j < 4; ++j) { v[j] = xr[64 * j]; w[j] = xr2[64 * j]; }
#pragma unroll
        for (int j = 0; j < 4; ++j) { s += (v[j].x * v[j].x + v[j].y * v[j].y) + (v[j].z * v[j].z + v[j].w * v[j].w); s2 += (w[j].x * w[j].x + w[j].y * w[j].y) + (w[j].z * w[j].z + w[j].w * w[j].w); }
        s = wave_sum(s); s2 = wave_sum(s2);
        GAS unsigned long long* o8 = (GAS unsigned long long*)(out + (size_t)m * DM) + C.lane; GAS unsigned long long* p8 = (GAS unsigned long long*)(out + (size_t)m2 * DM) + C.lane;
#pragma unroll
        for (int j = 0; j < 4; ++j) { o8[64 * j] = (unsigned long long)pk2(v[j].x, v[j].y) | ((unsigned long long)pk2(v[j].z, v[j].w) << 32); if (m2 != m) p8[64 * j] = (unsigned long long)pk2(w[j].x, w[j].y) | ((unsigned long long)pk2(w[j].z, w[j].w) << 32); }
        if (C.lane == 0) { ss[m] = (unsigned long long)(s * SS_SCALE); if (m2 != m) ss[m2] = (unsigned long long)(s2 * SS_SCALE); }
        if (out8) { GAS unsigned* q8 = (GAS unsigned*)(out8 + (size_t)m * DM) + C.lane; GAS unsigned* r8 = (GAS unsigned*)(out8 + (size_t)m2 * DM) + C.lane;
#pragma unroll
            for (int j = 0; j < 4; ++j) { q8[64 * j] = pg8::pk4_fp8(v[j].x * X8_SCALE, v[j].y * X8_SCALE, v[j].z * X8_SCALE, v[j].w * X8_SCALE);
                if (m2 != m) r8[64 * j] = pg8::pk4_fp8(w[j].x * X8_SCALE, w[j].y * X8_SCALE, w[j].z * X8_SCALE, w[j].w * X8_SCALE); } }
    }
}
__device__ __forceinline__ void attn_decode(int u, int& b, int& gj, int& rs, int& c, int& n) {
    const int bgj = u >> 7, blk = u & 127; b = bgj / 24; gj = bgj - b * 24; const int g = gj >> 3; rs = 2 * g; const int lg = 7 - rs;
    c = blk >> lg; n = blk & ((1 << lg) - 1);
}
__device__ __forceinline__ void attn_phase(const Ctx& C, bf16* Qp, const bf16* Kp, const bf16* Vp, float* LSE, const float* biasg, bf16* Op) {
    LAS unsigned char* lds = C.lds;
    constexpr int KOFF = 0, VOFF = 32768, VROWS = 400, BOFF = VOFF + VROWS * 128;
    const int tid = C.tid, lane = C.lane, w = C.wave;
    for (int i = tid; i < 24 * 132; i += 512) ((LAS float*)(lds + BOFF))[i] = biasg[i];
    for (int i = tid; i < (BOFF - KOFF) / 16; i += 512) ((LAS v4u*)(lds + KOFF))[i] = (v4u){0u, 0u, 0u, 0u};
    const int u0 = (int)((long)C.vcu * 6144 / C.G), u1 = (int)((long)(C.vcu + 1) * 6144 / C.G);
    const int q15 = lane & 15, g4 = lane >> 4;
    const int srow = tid >> 3, sch = tid & 7;
    v4u kreg[2], vreg[2]; bf16x8 qn0, qn1;
    int b, gj, rs, c, n;
#define ATT_ISSUE(u_) do { attn_decode((u_), b, gj, rs, c, n); \
        _Pragma("unroll") for (int i = 0; i < 2; ++i) { const int tok = ((128 * n + srow + 64 * i) << rs) + c; \
            const size_t off = ((size_t)(b * SEQ + tok)) * AW + gj * 64 + sch * 8; kreg[i] = *(const GAS v4u*)(Kp + off); vreg[i] = *(const GAS v4u*)(Vp + off); } \
        { const bf16* qr_ = Qp + ((size_t)(b * SEQ + (((128 * n + 16 * w + q15) << rs) + c))) * AW + gj * 64; qn0 = *(const GAS bf16x8*)(qr_ + 8 * g4); qn1 = *(const GAS bf16x8*)(qr_ + 32 + 8 * g4); } } while (0)
    __syncthreads();
    if (u0 < u1) {
        attn_decode(u0, b, gj, rs, c, n);
        if (n > 0) {
#pragma unroll
            for (int i = 0; i < 2; ++i) { const int kr = srow + 64 * i, tok = ((128 * (n - 1) + kr) << rs) + c; const size_t off = ((size_t)(b * SEQ + tok)) * AW + gj * 64 + sch * 8;
                const v4u kv = *(const GAS v4u*)(Kp + off), vv = *(const GAS v4u*)(Vp + off); const int pr = ((n - 1) & 1) * 128 + kr;
                *(LAS v4u*)(lds + KOFF + pr * 128 + ((sch ^ ((pr >> 1) & 7)) << 4)) = kv;
                *(LAS v4u*)(lds + VOFF + pr * 128 + ((((sch >> 1) ^ ((pr >> 1) & 3)) << 5) | ((sch & 1) << 4))) = vv; }
        }
        ATT_ISSUE(u0);
    }
    const int klane0 = KOFF + q15 * 128 + (((0 + g4) ^ ((q15 >> 1) & 7)) << 4), klane1 = KOFF + q15 * 128 + (((4 + g4) ^ ((q15 >> 1) & 7)) << 4);
    const int vswz = (2 * g4 + (q15 >> 3)) & 3;
    int vlane[4];
#pragma unroll
    for (int db = 0; db < 4; ++db) vlane[db] = VOFF + (4 * g4 + (q15 >> 2)) * 128 + ((db ^ vswz) << 5) + (q15 & 3) * 8;
    float bq[9][4]; int gj_have = -1;
    for (int u = u0; u < u1; ++u) {
        __syncthreads();
        attn_decode(u, b, gj, rs, c, n);
        const int n_cur = n, gj_cur = gj;
#pragma unroll
        for (int i = 0; i < 2; ++i) { const int pr = (n_cur & 1) * 128 + srow + 64 * i;
            *(LAS v4u*)(lds + KOFF + pr * 128 + ((sch ^ ((pr >> 1) & 7)) << 4)) = kreg[i];
            *(LAS v4u*)(lds + VOFF + pr * 128 + ((((sch >> 1) ^ ((pr >> 1) & 3)) << 5) | ((sch & 1) << 4))) = vreg[i]; }
        const int tokq = ((128 * n_cur + 16 * w + q15) << rs) + c;
        const size_t tokrow = (size_t)(b * SEQ + tokq);
        bf16* orow = Op + tokrow * AW + gj_cur * 64;
        const bf16x8 qf0 = qn0, qf1 = qn1;
        if (gj_cur != gj_have) { const LAS float* bt = (const LAS float*)(lds + BOFF) + gj_cur * 132;
#pragma unroll
            for (int t = 0; t < 9; ++t)
#pragma unroll
                for (int r = 0; r < 4; ++r) { const int delta = 128 + q15 - (16 * t + 4 * g4 + r); bq[t][r] = bt[delta < 0 ? 0 : (delta > 128 ? 128 : delta)]; }
            gj_have = gj_cur; }
        __syncthreads();
        if (u + 1 < u1) ATT_ISSUE(u + 1);
        const int flip = ((n_cur & 1) ^ 1) << 7;
        bf16x8 kf[9][2];
#pragma unroll
        for (int t = 0; t < 9; ++t) { const int pb = ((16 * w + 16 * t) ^ flip) * 128; kf[t][0] = *(const LAS bf16x8*)(lds + klane0 + pb); kf[t][1] = *(const LAS bf16x8*)(lds + klane1 + pb); }
        f32x4 s[9];
#pragma unroll
        for (int t = 0; t < 9; ++t) {
            f32x4 a = (f32x4){0.f, 0.f, 0.f, 0.f};
            a = __builtin_amdgcn_mfma_f32_16x16x32_bf16(kf[t][0], qf0, a, 0, 0, 0);
            s[t] = __builtin_amdgcn_mfma_f32_16x16x32_bf16(kf[t][1], qf1, a, 0, 0, 0);
            asm volatile("" : "+v"(s[t]) : "v"(kf[t][0]), "v"(kf[t][1]));
        }
        asm volatile("s_nop 15\n\ts_nop 15" : "+v"(s[0]), "+v"(s[1]), "+v"(s[2]), "+v"(s[3]), "+v"(s[4]), "+v"(s[5]), "+v"(s[6]), "+v"(s[7]), "+v"(s[8]));
        float mx = -1e30f;
#pragma unroll
        for (int t = 0; t < 9; ++t)
#pragma unroll
            for (int r = 0; r < 4; ++r) { const int kvl = 16 * t + 4 * g4 + r, delta = 128 + q15 - kvl;
                bool valid = true; if (t == 0) valid = delta <= 128; if (t == 8) valid = delta >= 0;
                float v = s[t][r] + bq[t][r]; v = valid ? v : -1e30f; s[t][r] = v; }
        if (n_cur == 0) {
#pragma unroll
            for (int t = 0; t < 8; ++t)
#pragma unroll
                for (int r = 0; r < 4; ++r) if (16 * w + 16 * t + 4 * g4 + r < 128) s[t][r] = -1e30f;
        }
#pragma unroll
        for (int t = 0; t < 9; ++t) mx = fmaxf(fmaxf(mx, fmaxf(s[t][0], s[t][1])), fmaxf(s[t][2], s[t][3]));
        mx = fmaxf(mx, __shfl_xor(mx, 16)); mx = fmaxf(mx, __shfl_xor(mx, 32));
        float sum = 0.f;
#pragma unroll
        for (int t = 0; t < 9; ++t)
#pragma unroll
            for (int r = 0; r < 4; ++r) { const float p = __builtin_amdgcn_exp2f(s[t][r] - mx); s[t][r] = p; sum += p; }
        sum += __shfl_xor(sum, 16); sum += __shfl_xor(sum, 32);
        f32x4 o[4];
#pragma unroll
        for (int db = 0; db < 4; ++db) o[db] = (f32x4){0.f, 0.f, 0.f, 0.f};
#pragma unroll
        for (int s5 = 0; s5 < 5; ++s5) {
            v4u pw; pw.x = cvtpk(s[2 * s5][0], s[2 * s5][1]); pw.y = cvtpk(s[2 * s5][2], s[2 * s5][3]);
            if (s5 < 4) { pw.z = cvtpk(s[2 * s5 + 1][0], s[2 * s5 + 1][1]); pw.w = cvtpk(s[2 * s5 + 1][2], s[2 * s5 + 1][3]); } else { pw.z = 0u; pw.w = 0u; }
            const bf16x8 pf = __builtin_bit_cast(bf16x8, pw);
            const int x0 = 16 * w + 32 * s5, x1 = x0 + 16;
            const int p0 = (x0 ^ flip) * 128, p1 = (x1 ^ flip) * 128;
            v4i16_t lo[4], hi[4];
#pragma unroll
            for (int db = 0; db < 4; ++db) { lo[db] = __builtin_amdgcn_ds_read_tr16_b64_v4i16((LAS v4i16_t*)(lds + vlane[db] + p0)); hi[db] = __builtin_amdgcn_ds_read_tr16_b64_v4i16((LAS v4i16_t*)(lds + vlane[db] + p1)); }
#pragma unroll
            for (int db = 0; db < 4; ++db) {
                const bf16x8 vf = (bf16x8){lo[db][0], lo[db][1], lo[db][2], lo[db][3], hi[db][0], hi[db][1], hi[db][2], hi[db][3]};
                o[db] = __builtin_amdgcn_mfma_f32_16x16x32_bf16(vf, pf, o[db], 0, 0, 0);
                asm volatile("" : "+v"(o[db]) : "v"(vf), "v"(pf));
            }
        }
        asm volatile("s_nop 15\n\ts_nop 15" : "+v"(o[0]), "+v"(o[1]), "+v"(o[2]), "+v"(o[3]));
        const float inv = 1.0f / sum;
#pragma unroll
        for (int db = 0; db < 4; ++db) { const unsigned long long wv = (unsigned long long)pk2(o[db][0] * inv, o[db][1] * inv) | ((unsigned long long)pk2(o[db][2] * inv, o[db][3] * inv) << 32);
            *(GAS unsigned long long*)(orow + 16 * db + 4 * g4) = wv; }
        if (g4 == 0) LSE[tokrow * 24 + gj_cur] = mx + log2f(sum);
    }
#undef ATT_ISSUE
    __syncthreads();
}
__device__ __forceinline__ void attn_combine(const Ctx& C, const bf16* Qp, const float* LSE, bf16* AO) {
    const int gw = C.vcu * NWAVES + C.wave, NGW = C.G * NWAVES, lane = C.lane, j = lane >> 3;
    for (int m0 = gw; m0 < NTOK; m0 += 2 * NGW) {
        const int m1 = (m0 + NGW < NTOK) ? m0 + NGW : m0;
        float l[2][3]; v4u q[2][3];
#pragma unroll
        for (int r = 0; r < 2; ++r) { const int m = r ? m1 : m0; const GAS float* lp = (const GAS float*)LSE + (size_t)m * 24 + j; l[r][0] = lp[0]; l[r][1] = lp[8]; l[r][2] = lp[16];
            const bf16* qr = Qp + (size_t)m * AW + 8 * lane; q[r][0] = *(const GAS v4u*)qr; q[r][1] = *(const GAS v4u*)(qr + 512); q[r][2] = *(const GAS v4u*)(qr + 1024); }
#pragma unroll
        for (int r = 0; r < 2; ++r) { const int m = r ? m1 : m0;
            const float mx = fmaxf(l[r][0], fmaxf(l[r][1], l[r][2])); float w0 = __builtin_amdgcn_exp2f(l[r][0] - mx), w1 = __builtin_amdgcn_exp2f(l[r][1] - mx), w2 = __builtin_amdgcn_exp2f(l[r][2] - mx);
            const float inv = 1.0f / (w0 + w1 + w2); w0 *= inv; w1 *= inv; w2 *= inv;
            v4u o;
#pragma unroll
            for (int k = 0; k < 4; ++k) { const float lo = w0 * pg8::bflo(q[r][0][k]) + w1 * pg8::bflo(q[r][1][k]) + w2 * pg8::bflo(q[r][2][k]), hi = w0 * pg8::bfhi(q[r][0][k]) + w1 * pg8::bfhi(q[r][1][k]) + w2 * pg8::bfhi(q[r][2][k]); o[k] = pk2(lo, hi); }
            if (r == 0 || m1 != m0) *(GAS v4u*)(AO + (size_t)m * (2 * AOUT) + 8 * lane) = o; }
    }
}

template <bool PASS2>
__device__ __forceinline__ void ssm_pass(const Ctx& C, int layer, const bf16* U, bf16* Z, f32x2v* E, const unsigned char* ws, const float* dskip) {
    LAS unsigned char* wl = C.lds + C.wave * 12800; LAS float* BU = (LAS float*)wl; LAS unsigned char* XS = wl + 8448;
    const int lane = C.lane, p = lane, r16 = lane & 15, kg = lane >> 4;
    const int gwv = C.vcu * NWAVES + C.wave, NGW = C.G * NWAVES;
    constexpr int RUN = 4, NRUN = BATCH * SSM_G * NCHUNK / RUN;
    for (int rn = gwv; rn < NRUN; rn += NGW) {
        const int bg = rn / (NCHUNK / RUN), k0 = (rn % (NCHUNK / RUN)) * RUN, b = bg >> 5, g = bg & 31, gi = layer * SSM_G + g;
        const f32x2v lam = ((const GAS f32x2v*)(ws + TAB_LAMB))[gi * 64 + p];
        bf16x8 bfr[8];
#pragma unroll
        for (int nt = 0; nt < 8; ++nt) bfr[nt] = *(const GAS bf16x8*)((const bf16*)(ws + TAB_BB) + ((size_t)(gi * 128 + 16 * nt + r16)) * 32 + 8 * kg);
        bf16x8 cfr[4], dfr; float dsk = 0.f;
        float xr = 0.f, xi = 0.f;
        if (PASS2) {
#pragma unroll
            for (int ks = 0; ks < 4; ++ks) cfr[ks] = *(const GAS bf16x8*)((const bf16*)(ws + TAB_CM) + ((size_t)(gi * 16 + r16)) * 128 + 32 * ks + 8 * kg);
            dsk = dskip[16 * g + r16];
            { const unsigned dbits = f2bf(dsk); v4u dw = (v4u){0u, 0u, 0u, 0u};
#pragma unroll
              for (int j = 0; j < 8; ++j) if (8 * kg + j == r16) dw[j >> 1] |= dbits << (16 * (j & 1));
              dfr = __builtin_bit_cast(bf16x8, dw); }
            float tr = lam.x, ti = lam.y;
#pragma unroll
            for (int q = 0; q < 7; ++q) { const float nr = tr * tr - ti * ti; ti = 2.f * tr * ti; tr = nr; }
            const GAS f32x2v* Eb = (const GAS f32x2v*)E + ((size_t)bg * NCHUNK) * 64 + p;
            for (int j = 0; j < k0; j += 4) {
                const f32x2v e0 = Eb[(size_t)(j + 0) * 64], e1 = Eb[(size_t)(j + 1) * 64], e2 = Eb[(size_t)(j + 2) * 64], e3 = Eb[(size_t)(j + 3) * 64];
                float nr;
                nr = tr * xr - ti * xi + e0.x; xi = tr * xi + ti * xr + e0.y; xr = nr;
                nr = tr * xr - ti * xi + e1.x; xi = tr * xi + ti * xr + e1.y; xr = nr;
                nr = tr * xr - ti * xi + e2.x; xi = tr * xi + ti * xr + e2.y; xr = nr;
                nr = tr * xr - ti * xi + e3.x; xi = tr * xi + ti * xr + e3.y; xr = nr;
            }
        }
        const bf16* urow = U + (size_t)(b * SEQ + k0 * CHUNK + r16) * SW + 16 * g + 8 * kg;
        for (int kk = 0; kk < RUN; ++kk) {
            const int k = k0 + kk;
            if (!PASS2) { xr = 0.f; xi = 0.f; }
            for (int sub = 0; sub < 8; ++sub) {
                const int tok0 = b * SEQ + k * CHUNK + sub * 16;
                const bf16x8 a = *(const GAS bf16x8*)(urow + (size_t)(kk * 8 + sub) * 16 * SW);
                f32x4 dd[8];
#pragma unroll
                for (int nt = 0; nt < 8; ++nt) dd[nt] = __builtin_amdgcn_mfma_f32_16x16x32_bf16(a, bfr[nt], (f32x4){0.f, 0.f, 0.f, 0.f}, 0, 0, 0);
                asm volatile("s_nop 15\n\ts_nop 15" : "+v"(dd[0]), "+v"(dd[1]), "+v"(dd[2]), "+v"(dd[3]), "+v"(dd[4]), "+v"(dd[5]), "+v"(dd[6]), "+v"(dd[7]) : "v"(a));
#pragma unroll
                for (int nt = 0; nt < 8; ++nt)
#pragma unroll
                    for (int r = 0; r < 4; ++r) BU[(4 * kg + r) * 132 + 16 * nt + r16] = dd[nt][r];
#pragma unroll
                for (int t = 0; t < 16; ++t) { const f32x2v bu = *(const LAS f32x2v*)(BU + t * 132 + 2 * p);
                    const float nr = lam.x * xr - lam.y * xi + bu.x; xi = lam.x * xi + lam.y * xr + bu.y; xr = nr;
                    if (PASS2) *(LAS unsigned*)(XS + t * 272 + 4 * p) = cvtpk(xr, xi); }
                if (PASS2) {
                    f32x4 y = (f32x4){0.f, 0.f, 0.f, 0.f};
#pragma unroll
                    for (int ks = 0; ks < 4; ++ks) { const bf16x8 afr = *(const LAS bf16x8*)(XS + r16 * 272 + 64 * ks + 16 * kg); y = __builtin_amdgcn_mfma_f32_16x16x32_bf16(afr, cfr[ks], y, 0, 0, 0); asm volatile("" : "+v"(y) : "v"(afr)); }
                    y = __builtin_amdgcn_mfma_f32_16x16x32_bf16(a, dfr, y, 0, 0, 0);
                    asm volatile("s_nop 15\n\ts_nop 15" : "+v"(y) : "v"(a));
#pragma unroll
                    for (int r = 0; r < 4; ++r) { const size_t idx = (size_t)(tok0 + 4 * kg + r) * SW + 16 * g + r16; const float yy = y[r];
                        const float z = yy * sigm_f(1.5957691216057308f * (yy + 0.044715f * yy * yy * yy)); Z[idx] = (bf16)f2bf(z); }
                }
            }
            if (!PASS2) ((GAS f32x2v*)E)[((size_t)bg * NCHUNK + k) * 64 + p] = (f32x2v){xr, xi};
        }
    }
}
typedef unsigned u32x2b __attribute__((ext_vector_type(2)));
__device__ __forceinline__ f32x4 bf4(u32x2b w) { return (f32x4){pg8::bflo(w.x), pg8::bfhi(w.x), pg8::bflo(w.y), pg8::bfhi(w.y)}; }
constexpr int XO_LD = 2 * DM;
constexpr int ROUTE_LDS = 12544;
__device__ __forceinline__ void route_pass1(const Ctx& C, const bf16* x, const float* g2, const float* wrouter, unsigned char* ws, int wave_lo) {
    const int TPW = NTOK / C.G, t0 = C.vcu * TPW, lane = C.lane;
    LAS int* te = (LAS int*)(C.lds + ROUTE_LDS); LAS f32x2v* tg = (LAS f32x2v*)(C.lds + ROUTE_LDS + 1024); LAS int* lcnt = (LAS int*)(C.lds + ROUTE_LDS + 3072);
    if (C.tid < 8) lcnt[C.tid] = 0;
    f32x4 gv[4];
#pragma unroll
    for (int j = 0; j < 4; ++j) gv[j] = ((const f32x4*)g2)[lane + 64 * j];
    if (C.wave >= wave_lo)
    for (int r = C.wave - wave_lo; r < TPW; r += NWAVES - wave_lo) {
        const GAS u32x2b* xr = (const GAS u32x2b*)(x + (size_t)(t0 + r) * XO_LD) + lane;
        f32x4 v[4]; float s = 0.f;
#pragma unroll
        for (int j = 0; j < 4; ++j) { v[j] = bf4(xr[64 * j]); s += (v[j].x * v[j].x + v[j].y * v[j].y) + (v[j].z * v[j].z + v[j].w * v[j].w); }
        const float rstd = 1.f / sqrtf(wave_sum(s) * (1.f / DM) + EPS);
        float lg[8];
#pragma unroll
        for (int e = 0; e < 8; ++e) lg[e] = 0.f;
#pragma unroll
        for (int j = 0; j < 4; ++j) { const f32x4 h = v[j] * rstd * gv[j];
#pragma unroll
            for (int i = 0; i < 4; ++i) { const GAS f32x4* wp = (const GAS f32x4*)(wrouter + (size_t)(4 * lane + 256 * j + i) * 8); const f32x4 wa = wp[0], wb = wp[1];
                lg[0] += h[i] * wa.x; lg[1] += h[i] * wa.y; lg[2] += h[i] * wa.z; lg[3] += h[i] * wa.w; lg[4] += h[i] * wb.x; lg[5] += h[i] * wb.y; lg[6] += h[i] * wb.z; lg[7] += h[i] * wb.w; } }
#pragma unroll
        for (int e = 0; e < 8; ++e) lg[e] = wave_sum(lg[e]);
        if (lane == 0) {
            int e0 = 0; float v0 = lg[0];
#pragma unroll
            for (int e = 1; e < 8; ++e) if (lg[e] > v0) { v0 = lg[e]; e0 = e; }
            int e1 = -1; float v1 = -3.0e38f;
#pragma unroll
            for (int e = 0; e < 8; ++e) if (e != e0 && lg[e] > v1) { v1 = lg[e]; e1 = e; }
            const float g0 = 1.0f / (1.0f + expf(v1 - v0));
            te[r] = e0 | (e1 << 8); tg[r] = (f32x2v){g0, 1.0f - g0};
        }
    }
    __syncthreads();
    if (C.tid == 0) { for (int t = 0; t < TPW; ++t) { const int e = te[t]; const int r0 = lcnt[e & 255]; lcnt[e & 255] = r0 + 1; const int r1 = lcnt[e >> 8]; lcnt[e >> 8] = r1 + 1; const int tok = t0 + t;
        ((int*)(ws + TOK_E))[tok] = e; ((i32x2v*)(ws + TOK_R))[tok] = (i32x2v){r0, r1}; ((f32x2v*)(ws + TOK_G))[tok] = tg[t]; } }
    __syncthreads();
    if (C.tid < 8) ((int*)(ws + CNTWG))[C.vcu * 8 + C.tid] = lcnt[C.tid];
}
__device__ __forceinline__ int router_lds(int p) { return (p >> 8) * 16384 + 8448 + (p & 255) * 16; }
__device__ __forceinline__ void stage_router(const Ctx& C, const float* wrouter) {
    for (int q = C.tid; q < 2048; q += NWAVES * 64) { const int ln = q & 63, g = q >> 6, h = g & 1, i = (g >> 1) & 3, j = g >> 3;
        *(LAS f32x4*)(C.lds + router_lds(q)) = *(const GAS f32x4*)(wrouter + (size_t)(4 * ln + 256 * j + i) * 8 + 4 * h); }
}
__device__ __forceinline__ void route_row(const Ctx& C, const f32x4 (&v)[4], const f32x4 (&gv)[4], int r, LAS int* te, LAS f32x2v* tg) {
    const int lane = C.lane; float s = 0.f;
#pragma unroll
    for (int j = 0; j < 4; ++j) s += (v[j].x * v[j].x + v[j].y * v[j].y) + (v[j].z * v[j].z + v[j].w * v[j].w);
    const float rstd = 1.f / sqrtf(wave_sum(s) * (1.f / DM) + EPS);
    float lg[8];
#pragma unroll
    for (int e = 0; e < 8; ++e) lg[e] = 0.f;
#pragma unroll
    for (int j = 0; j < 4; ++j) { const f32x4 h = v[j] * rstd * gv[j];
#pragma unroll
        for (int i = 0; i < 4; ++i) { const f32x4 wa = *(const LAS f32x4*)(C.lds + router_lds(((j * 4 + i) * 2 + 0) * 64) + lane * 16), wb = *(const LAS f32x4*)(C.lds + router_lds(((j * 4 + i) * 2 + 1) * 64) + lane * 16);
            lg[0] += h[i] * wa.x; lg[1] += h[i] * wa.y; lg[2] += h[i] * wa.z; lg[3] += h[i] * wa.w; lg[4] += h[i] * wb.x; lg[5] += h[i] * wb.y; lg[6] += h[i] * wb.z; lg[7] += h[i] * wb.w; } }
#pragma unroll
    for (int e = 0; e < 8; ++e) lg[e] = wave_sum(lg[e]);
    if (lane == 0) {
        int e0 = 0; float v0 = lg[0];
#pragma unroll
        for (int e = 1; e < 8; ++e) if (lg[e] > v0) { v0 = lg[e]; e0 = e; }
        int e1 = -1; float v1 = -3.0e38f;
#pragma unroll
        for (int e = 0; e < 8; ++e) if (e != e0 && lg[e] > v1) { v1 = lg[e]; e1 = e; }
        const float g0 = 1.0f / (1.0f + expf(v1 - v0));
        te[r] = e0 | (e1 << 8); tg[r] = (f32x2v){g0, 1.0f - g0};
    }
}
__device__ __forceinline__ void r1_fused(const Ctx& C, const float* const* in, const bf16* x, const float* g2, const float* wrouter, unsigned char* ws) {
    const int TPW = NTOK / C.G, t0 = C.vcu * TPW, lane = C.lane;
    LAS int* te = (LAS int*)(C.lds + ROUTE_LDS); LAS f32x2v* tg = (LAS f32x2v*)(C.lds + ROUTE_LDS + 1024); LAS int* lcnt = (LAS int*)(C.lds + ROUTE_LDS + 3072);
    if (C.tid < 8) lcnt[C.tid] = 0;
    stage_router(C, wrouter);
    f32x4 gv[4];
#pragma unroll
    for (int j = 0; j < 4; ++j) gv[j] = ((const f32x4*)g2)[lane + 64 * j];
    __syncthreads();
    LAS float* scr = (LAS float*)(C.lds + C.wave * 16384);
    const int gw = C.vcu * NWAVES + C.wave, NGW = C.G * NWAVES;
    constexpr int IG = 16 * 112, ID = 56 * 32, IE = 2 * IG + ID, NITEMS = NEXP * IE;
    int rrow = C.wave;
    for (int it = gw; it < NITEMS; it += NGW) {
        const bool has_row = rrow < TPW;
        u32x2b xw[4];
        if (has_row) { const GAS u32x2b* xr = (const GAS u32x2b*)(x + (size_t)(t0 + rrow) * XO_LD) + lane;
#pragma unroll
            for (int j = 0; j < 4; ++j) xw[j] = xr[64 * j]; }
        const int e = it / IE; int r = it - e * IE;
        const float* W; unsigned char* WT; int K, ldw, ncols, row0, mode; float scale;
        if (r < 2 * IG) { const int up = r >= IG; r -= up * IG; W = as_global(in[22 + up]) + (size_t)e * DM * FFE; K = DM; ldw = FFE; ncols = FFE; WT = ws + WS_MW13 + (size_t)e * 2 * FFE * DM; row0 = 128 * up; mode = 1; scale = MOE_W13_SCALE; }
        else { r -= 2 * IG; W = as_global(in[24]) + (size_t)e * FFE * DM; K = FFE; ldw = DM; ncols = DM; WT = ws + WS_MW2 + (size_t)e * DM * FFE; row0 = 0; mode = 0; scale = MOE_W2_SCALE; }
        const int nblk = ncols / 32, kb = r / nblk, nb = r % nblk, k0 = 64 * kb, n0 = 32 * nb;
        float tv[32];
#pragma unroll
        for (int i = 0; i < 32; ++i) tv[i] = W[(size_t)(k0 + 2 * i + (lane >> 5)) * ldw + n0 + (lane & 31)];
        if (has_row) { f32x4 v[4];
#pragma unroll
            for (int j = 0; j < 4; ++j) v[j] = bf4(xw[j]);
            route_row(C, v, gv, rrow, te, tg); }
        rrow += NWAVES;
#pragma unroll
        for (int i = 0; i < 32; ++i) scr[(2 * i + (lane >> 5)) * 33 + (lane & 31)] = tv[i] * scale;
        LDS_WAIT(); asm volatile("" ::: "memory");
        const int c = lane & 7;
#pragma unroll
        for (int j = 0; j < 4; ++j) { const int n = (lane >> 3) + 8 * j; const LAS float* s = scr + (8 * c) * 33 + n;
            u32x2b o; o.x = pg8::pk4_fp8(s[0 * 33], s[1 * 33], s[2 * 33], s[3 * 33]); o.y = pg8::pk4_fp8(s[4 * 33], s[5 * 33], s[6 * 33], s[7 * 33]);
            const int nn = n0 + n; const int drow = mode ? row0 + (nn >> 7) * 256 + (nn & 127) : row0 + nn;
            *(GAS u32x2b*)(WT + (size_t)drow * K + k0 + 8 * c) = o; }
        LDS_WAIT(); asm volatile("" ::: "memory");
    }
    for (; rrow < TPW; rrow += NWAVES) {
        const GAS u32x2b* xr = (const GAS u32x2b*)(x + (size_t)(t0 + rrow) * XO_LD) + lane; f32x4 v[4];
#pragma unroll
        for (int j = 0; j < 4; ++j) v[j] = bf4(xr[64 * j]);
        route_row(C, v, gv, rrow, te, tg); }
    __syncthreads();
    if (C.tid == 0) { for (int t = 0; t < TPW; ++t) { const int e = te[t]; const int r0 = lcnt[e & 255]; lcnt[e & 255] = r0 + 1; const int r1 = lcnt[e >> 8]; lcnt[e >> 8] = r1 + 1; const int tok = t0 + t;
        ((int*)(ws + TOK_E))[tok] = e; ((i32x2v*)(ws + TOK_R))[tok] = (i32x2v){r0, r1}; ((f32x2v*)(ws + TOK_G))[tok] = tg[t]; } }
    __syncthreads();
    if (C.tid < 8) ((int*)(ws + CNTWG))[C.vcu * 8 + C.tid] = lcnt[C.tid];
}
__device__ __forceinline__ void moe_bases(const Ctx& C, const unsigned char* ws) {
    LAS int* ctl = (LAS int*)(C.lds + LDSCTL_OFF);
    LAS int* lc = (LAS int*)(C.lds + 32768);
    __syncthreads();
    for (int i = C.tid; i < C.G * 8; i += NWAVES * 64) lc[i] = __hip_atomic_load((const int*)(ws + CNTWG) + i, __ATOMIC_RELAXED, __HIP_MEMORY_SCOPE_AGENT);
    __syncthreads();
    { const int e = C.wave; int tot = 0, mine = 0;
        for (int w = C.lane; w < C.G; w += 64) { const int cv = lc[w * 8 + e]; tot += cv; if (w < C.vcu) mine += cv; }
#pragma unroll
        for (int o = 1; o < 64; o <<= 1) { tot += __shfl_xor(tot, o); mine += __shfl_xor(mine, o); }
        if (C.lane == 0) { ctl[32 + e] = tot; ctl[40 + e] = mine; } }
    __syncthreads();
    if (C.tid == 0) { int tb = 0; for (int e = 0; e < 8; ++e) { ctl[e] = tb; ctl[16 + e] = tb * 256 + ctl[40 + e]; tb += (ctl[32 + e] + 255) >> 8; } ctl[8] = tb; }
    __syncthreads();
}
__device__ __forceinline__ void route_pass2(const Ctx& C, const bf16* x, const float* g2, unsigned char* ws) {
    const int TPW = NTOK / C.G, t0 = C.vcu * TPW, lane = C.lane;
    LAS int* ctl = (LAS int*)(C.lds + LDSCTL_OFF); LAS i32x2v* sl = (LAS i32x2v*)(C.lds + ROUTE_LDS);
    moe_bases(C, ws);
    if (C.tid < TPW) { const int tok = t0 + C.tid; const int e = ((const int*)(ws + TOK_E))[tok]; const i32x2v r = ((const i32x2v*)(ws + TOK_R))[tok];
        const i32x2v s = (i32x2v){ctl[16 + (e & 255)] + r.x, ctl[16 + (e >> 8)] + r.y}; ((i32x2v*)(ws + TOK_S))[tok] = s; sl[C.tid] = s; }
    __syncthreads();
    f32x4 gv[4];
#pragma unroll
    for (int j = 0; j < 4; ++j) gv[j] = ((const f32x4*)g2)[lane + 64 * j];
    unsigned char* XS = ws + WS_XS;
    for (int r = C.wave; r < TPW; r += 2 * NWAVES) {
        const int r2 = r + NWAVES;
        const GAS u32x2b* xr = (const GAS u32x2b*)(x + (size_t)(t0 + r) * XO_LD) + lane; const GAS u32x2b* xq = (const GAS u32x2b*)(x + (size_t)(t0 + r2) * XO_LD) + lane;
        f32x4 v[4], w[4]; float s = 0.f, s2 = 0.f;
#pragma unroll
        for (int j = 0; j < 4; ++j) { v[j] = bf4(xr[64 * j]); w[j] = bf4(xq[64 * j]); }
#pragma unroll
        for (int j = 0; j < 4; ++j) { s += (v[j].x * v[j].x + v[j].y * v[j].y) + (v[j].z * v[j].z + v[j].w * v[j].w); s2 += (w[j].x * w[j].x + w[j].y * w[j].y) + (w[j].z * w[j].z + w[j].w * w[j].w); }
        const float rstd = 1.f / sqrtf(wave_sum(s) * (1.f / DM) + EPS), rstd2 = 1.f / sqrtf(wave_sum(s2) * (1.f / DM) + EPS);
        const i32x2v st = sl[r], st2 = sl[r2];
        GAS unsigned* o0 = (GAS unsigned*)(XS + (size_t)st.x * DM) + lane; GAS unsigned* o1 = (GAS unsigned*)(XS + (size_t)st.y * DM) + lane;
        GAS unsigned* p0 = (GAS unsigned*)(XS + (size_t)st2.x * DM) + lane; GAS unsigned* p1 = (GAS unsigned*)(XS + (size_t)st2.y * DM) + lane;
#pragma unroll
        for (int j = 0; j < 4; ++j) { const f32x4 h = v[j] * rstd * gv[j]; const unsigned wv = pg8::pk4_fp8(h.x, h.y, h.z, h.w); o0[64 * j] = wv; o1[64 * j] = wv;
            const f32x4 h2 = w[j] * rstd2 * gv[j]; const unsigned wv2 = pg8::pk4_fp8(h2.x, h2.y, h2.z, h2.w); p0[64 * j] = wv2; p1[64 * j] = wv2; }
    }
}
__device__ __forceinline__ void final_rows(const Ctx& C, const bf16* xb, float* x, const float* fg, const unsigned char* ws) {
    const int gw = C.vcu * NWAVES + C.wave, NGW = C.G * NWAVES, lane = C.lane;
    f32x4 gv[4];
#pragma unroll
    for (int j = 0; j < 4; ++j) gv[j] = ((const GAS f32x4*)fg)[lane + 64 * j];
    const bf16* XS = (const bf16*)(ws + WS_Y);
    for (int m0 = gw; m0 < NTOK; m0 += 2 * NGW) {
        const int m1 = (m0 + NGW < NTOK) ? m0 + NGW : m0;
        const i32x2v sa = ((const GAS i32x2v*)(ws + TOK_S))[m0], sb = ((const GAS i32x2v*)(ws + TOK_S))[m1]; const f32x2v ga = ((const GAS f32x2v*)(ws + TOK_G))[m0], gb = ((const GAS f32x2v*)(ws + TOK_G))[m1];
        f32x4 v[2][4]; unsigned long long ya[2][4], yb[2][4];
#pragma unroll
        for (int r = 0; r < 2; ++r) { const int m = r ? m1 : m0; const i32x2v st = r ? sb : sa;
            const GAS u32x2b* xr = (const GAS u32x2b*)(xb + (size_t)m * XO_LD) + lane;
            const GAS unsigned long long* y0 = (const GAS unsigned long long*)(XS + (size_t)st.x * DM) + lane; const GAS unsigned long long* y1 = (const GAS unsigned long long*)(XS + (size_t)st.y * DM) + lane;
#pragma unroll
            for (int j = 0; j < 4; ++j) { v[r][j] = bf4(xr[64 * j]); ya[r][j] = y0[64 * j]; yb[r][j] = y1[64 * j]; } }
#pragma unroll
        for (int r = 0; r < 2; ++r) { const int m = r ? m1 : m0; const f32x2v gt = r ? gb : ga; float s = 0.f;
#pragma unroll
            for (int j = 0; j < 4; ++j) { const unsigned a0 = (unsigned)ya[r][j], a1 = (unsigned)(ya[r][j] >> 32), b0 = (unsigned)yb[r][j], b1 = (unsigned)(yb[r][j] >> 32);
                v[r][j].x += gt.x * pg8::bflo(a0) + gt.y * pg8::bflo(b0); v[r][j].y += gt.x * pg8::bfhi(a0) + gt.y * pg8::bfhi(b0);
                v[r][j].z += gt.x * pg8::bflo(a1) + gt.y * pg8::bflo(b1); v[r][j].w += gt.x * pg8::bfhi(a1) + gt.y * pg8::bfhi(b1);
                s += (v[r][j].x * v[r][j].x + v[r][j].y * v[r][j].y) + (v[r][j].z * v[r][j].z + v[r][j].w * v[r][j].w); }
            const float rstd = 1.f / sqrtf(wave_sum(s) * (1.f / DM) + EPS);
            if (r == 0 || m1 != m0) { GAS f32x4* xw = (GAS f32x4*)(x + (size_t)m * DM) + lane;
#pragma unroll
                for (int j = 0; j < 4; ++j) xw[64 * j] = v[r][j] * rstd * gv[j]; } }
    }
}
struct MoeOrder {
    pg8::StaticOrder so; int t0; int tb1, tb2, tb3, tb4, tb5, tb6, tb7; size_t estride;
    __device__ __forceinline__ bool next(int i, pg8::Unit& u) const {
        if (!so.next(i, u)) return false;
        u.pm += t0; const int e = (u.pm >= tb1) + (u.pm >= tb2) + (u.pm >= tb3) + (u.pm >= tb4) + (u.pm >= tb5) + (u.pm >= tb6) + (u.pm >= tb7);
        u.boff = (size_t)e * estride; return true;
    }
    __device__ __forceinline__ void a_ready(const pg8::Unit&) const {}
    __device__ __forceinline__ void done(const pg8::Unit&) const {}
};
#ifndef DBG_SSM2
#define DBG_SSM2 0
#endif
#ifndef DBG_ATT2
#define DBG_ATT2 0
#endif
#ifndef MK_SPLIT
#define MK_SPLIT 0
#endif
#ifndef DBG_SUM_BYTES
#define DBG_SUM_BYTES 0
#define DBG_SUM_OFF 8
#define DBG_SUM_MASK 0xffffffffu
#endif
#ifndef DBG_AX
#define DBG_AX 0
#define DBG_AX_N 0
#define DBG_AX_LIVE_G 77
#define DBG_AX_LIVE 1
#endif
#ifndef GEMM_SP2
#define GEMM_SP2 true
#endif
struct ProbeOrder { pg8::StaticOrder so; int mode;
    __device__ __forceinline__ bool next(int i, pg8::Unit& u) const { if (!so.next(i, u)) return false; if (mode == 2) { u.pm = 0; u.pn = 0; } else if (mode == 3) u.pn = 0; else if (mode == 4) u.pm = 0; return true; }
    __device__ __forceinline__ void a_ready(const pg8::Unit&) const {}
    __device__ __forceinline__ void done(const pg8::Unit&) const {}
};
struct Args { const float* in[26]; float* out; unsigned char* ws; int l, p; };
#if MK_SPLIT
#define RUN_PHASE_INLINE __forceinline__
#else
#define RUN_PHASE_INLINE __noinline__
#endif
__device__ __forceinline__ void make_ctx(Ctx& C, unsigned char* lds_raw) { int t_ = threadIdx.x; asm volatile("" : "+v"(t_));
    C.lds = (LAS unsigned char*)lds_raw; C.tid = t_; C.lane = t_ & 63; C.wave = __builtin_amdgcn_readfirstlane(t_ >> 6);
    C.G = gridDim.x; { const int bx = blockIdx.x; C.vcu = (C.G % 8 == 0) ? (bx % 8) * (C.G / 8) + bx / 8 : bx; } }
enum { PH_P0 = 0, PH_A, PH_B, PH_C, PH_D, PH_E, PH_F, PH_N2, PH_FUP, PH_FDN, PH_N1, PH_R1, PH_R2, PH_MOE, PH_FIN, PH_COUNT };
template <int PH> __device__ __forceinline__ void run_phase(unsigned char* lds_raw, const float* const* in, float* out, unsigned char* ws, int l, int p) {
    ws = as_global(ws); out = as_global(out);
    Ctx C; make_ctx(C, lds_raw);
    LAS unsigned char* ring = C.lds;
    unsigned char* wl = ws + WS_WS + (size_t)l * WL_STRIDE;
    bf16* Hb = (bf16*)(ws + WS_H); bf16* QP = (bf16*)(ws + WS_QP); bf16* KP = (bf16*)(ws + WS_KP); bf16* VP = (bf16*)(ws + WS_VP);
    bf16* Ub = (bf16*)(ws + WS_U); bf16* Zb = (bf16*)(ws + WS_Z); bf16* AOb = (bf16*)(ws + WS_AO); bf16* Gb = (bf16*)(ws + WS_G); bf16* Mb = (bf16*)(ws + WS_M); bf16* ZGb = (bf16*)(ws + WS_ZG);
    float* LSE = (float*)(ws + WS_LSE); f32x2v* Eb = (f32x2v*)(ws + WS_E);
    if constexpr (PH == PH_P0) {
        build_tables(C, as_global(in[1]), as_global(in[4]), as_global(in[5]), as_global(in[6]), as_global(in[7]), as_global(in[8]), as_global(in[9]), as_global(in[10]), ws);
        convert_small_weights(C, in, ws);
        prep_rows(C, as_global(in[0]), Hb, (unsigned long long*)(ws + SS_P0), GATE_FP8 ? (unsigned char*)out : nullptr);
    } else if constexpr (PH == PH_A) {
#if QK_FP8
        {
            pg8::Gemm g{(const bf16*)out, (const bf16*)(wl + WL_QKVU), NTOK, NQK, DM / 2, E8_W13, E8_X}; pg8::StaticOrder S; S.init(NTOK, NQK, C.G, (int)blockIdx.x);
            pg8::EpiProj E{QP, KP, VP, Ub, 0.125f * LOG2E, (const unsigned long long*)(ws + (l == 0 ? SS_P0 : SS_B)), 0};
            pg8::gemm_phase<pg8::EpiProj, pg8::StaticOrder, true, true, true>(ring, g, S, E); }
        __syncthreads();
        {
            pg8::Gemm g{Hb, (const bf16*)(wl + WL_QKVU + WL_VU_OFF), NTOK, NQKVU - NQK, DM}; pg8::StaticOrder S; S.init(NTOK, NQKVU - NQK, C.G, (int)blockIdx.x);
            pg8::EpiProj E{QP, KP, VP, Ub, 0.125f * LOG2E, (const unsigned long long*)(ws + (l == 0 ? SS_P0 : SS_B)), NQK / 256};
            pg8::gemm_phase<pg8::EpiProj, pg8::StaticOrder, true, GEMM_SP2>(ring, g, S, E); }
#else
        pg8::Gemm g{Hb, (const bf16*)(wl + WL_QKVU), NTOK, NQKVU, DM}; pg8::StaticOrder S; S.init(NTOK, NQKVU, C.G, (int)blockIdx.x);
        pg8::EpiProj E{QP, KP, VP, Ub, 0.125f * LOG2E, (const unsigned long long*)(ws + (l == 0 ? SS_P0 : SS_B)), 0};
        pg8::gemm_phase<pg8::EpiProj, pg8::StaticOrder, true, GEMM_SP2>(ring, g, S, E);
#endif
    } else if constexpr (PH == PH_B) {
        if (DBG_ATT2) attn_phase(C, QP, KP, VP, LSE, (const float*)(ws + TAB_BIAS), (bf16*)(ws + WS_Z));
        attn_phase(C, QP, KP, VP, LSE, (const float*)(ws + TAB_BIAS), QP);
        ssm_pass<false>(C, l, Ub, nullptr, Eb, ws, nullptr);
        if (DBG_SSM2) ssm_pass<false>(C, l, Ub, nullptr, Eb, ws, nullptr);
    } else if constexpr (PH == PH_C) {
        ssm_pass<true>(C, l, Ub, Zb, Eb, ws, as_global(in[11]) + (size_t)l * SW);
        if (DBG_SSM2) ssm_pass<true>(C, l, Ub, Zb, Eb, ws, as_global(in[11]) + (size_t)l * SW);
        if (DBG_SSM2 == 2) attn_combine(C, QP, LSE, AOb);
        attn_combine(C, QP, LSE, AOb);
        __syncthreads();
        pg8::StaticOrder S; S.init(NTOK, NGATE, C.G, (int)blockIdx.x);
        pg8::EpiSig E{Gb, NGATE, (const unsigned long long*)(ws + (l == 0 ? SS_P0 : SS_B))};
#if GATE_FP8
        pg8::Gemm g{(const bf16*)out, (const bf16*)(wl + WL_G), NTOK, NGATE, DM / 2, E8_W13, E8_X};
        pg8::gemm_phase<pg8::EpiSig, pg8::StaticOrder, true, true, true>(ring, g, S, E);
#else
        pg8::Gemm g{Hb, (const bf16*)(wl + WL_G), NTOK, NGATE, DM};
        pg8::gemm_phase<pg8::EpiSig, pg8::StaticOrder, true, GEMM_SP2>(ring, g, S, E);
#endif
    } else if constexpr (PH == PH_D) {
        pg8::Gemm g{Zb, (const bf16*)(wl + WL_GLU), NTOK, SW, SW}; pg8::StaticOrder S; S.init(NTOK, SW, C.G, (int)blockIdx.x);
        pg8::EpiGlu E{Zb, AOb + AOUT, SW, 2 * AOUT, as_global(in[13]) + (size_t)l * SW};
        pg8::gemm_phase<pg8::EpiGlu, pg8::StaticOrder, true, GEMM_SP2>(ring, g, S, E);
    } else if constexpr (PH == PH_E) {
        pg8::Gemm g{AOb, (const bf16*)(wl + WL_ABR), NTOK, DM, 2 * AOUT}; pg8::StaticOrder S; S.init(NTOK, DM, C.G, (int)blockIdx.x);
        pg8::EpiGateMid E{Gb, NGATE, DM, Mb, DM};
        pg8::gemm_phase<pg8::EpiGateMid, pg8::StaticOrder, true, GEMM_SP2>(ring, g, S, E);
    } else if constexpr (PH == PH_F) {
        pg8::Gemm g{Mb, (const bf16*)(wl + WL_OUT), NTOK, DM, DM}; pg8::StaticOrder S; S.init(NTOK, DM, C.G, (int)blockIdx.x);
        if (l == 0) { pg8::EpiResidB<true> E{Hb, DM, Hb, DM, (unsigned long long*)(ws + SS_A), nullptr};
            pg8::gemm_phase<pg8::EpiResidB<true>, pg8::StaticOrder, true, GEMM_SP2>(ring, g, S, E); }
        else { pg8::EpiResidB<false> E{Hb, DM, (bf16*)out, XO_LD, nullptr, nullptr};
            pg8::gemm_phase<pg8::EpiResidB<false>, pg8::StaticOrder, true, GEMM_SP2>(ring, g, S, E); }
    } else if constexpr (PH == PH_N2) {
    } else if constexpr (PH == PH_FUP) {
        pg8::Gemm g{Hb, (const bf16*)(ws + WS_W13), NTOK, 2 * FF, DM}; pg8::StaticOrder S; S.init(NTOK, 2 * FF, C.G, (int)blockIdx.x);
        pg8::EpiSwiGlu E{(bf16*)(ws + WS_HID), FF, (const unsigned long long*)(ws + SS_A)};
        pg8::gemm_phase<pg8::EpiSwiGlu, pg8::StaticOrder, true, GEMM_SP2>(ring, g, S, E);
    } else if constexpr (PH == PH_FDN) {
        pg8::Gemm g{(const bf16*)(ws + WS_HID), (const bf16*)(ws + WS_W2), NTOK, DM, FF}; pg8::StaticOrder S; S.init(NTOK, DM, C.G, (int)blockIdx.x);
        pg8::EpiResidB<true> E{Hb, DM, Hb, DM, (unsigned long long*)(ws + SS_B), GATE_FP8 ? (unsigned char*)out : nullptr};
        pg8::gemm_phase<pg8::EpiResidB<true>, pg8::StaticOrder, true, GEMM_SP2>(ring, g, S, E);
    } else if constexpr (PH == PH_N1) {
    } else if constexpr (PH == PH_R1) {
        r1_fused(C, in, (const bf16*)out, as_global(in[17]) + DM, as_global(in[21]), ws);
    } else if constexpr (PH == PH_R2) {
#ifndef DBG_MB
#define DBG_MB 0
#endif
        for (int rr = 0; rr < DBG_MB; ++rr) moe_bases(C, ws);
        route_pass2(C, (const bf16*)out, as_global(in[17]) + DM, ws);
    } else if constexpr (PH == PH_MOE) {
        moe_bases(C, ws);
        const LAS int* tbl = (const LAS int*)(C.lds + LDSCTL_OFF);
        const int tb1 = __builtin_amdgcn_readfirstlane(tbl[1]), tb2 = __builtin_amdgcn_readfirstlane(tbl[2]), tb3 = __builtin_amdgcn_readfirstlane(tbl[3]), tb4 = __builtin_amdgcn_readfirstlane(tbl[4]),
                  tb5 = __builtin_amdgcn_readfirstlane(tbl[5]), tb6 = __builtin_amdgcn_readfirstlane(tbl[6]), tb7 = __builtin_amdgcn_readfirstlane(tbl[7]), nT = __builtin_amdgcn_readfirstlane(tbl[8]);
        if (p >= 1) {
            pg8::Gemm g{(const bf16*)(ws + WS_HID0), (const bf16*)(ws + WS_MW2), nT * 256, DM, FFE / 2, E8_W2, E8_HID};
            MoeOrder S; S.so.init(nT * 256, DM, C.G, (int)blockIdx.x); S.t0 = 0; S.tb1 = tb1; S.tb2 = tb2; S.tb3 = tb3; S.tb4 = tb4; S.tb5 = tb5; S.tb6 = tb6; S.tb7 = tb7; S.estride = (size_t)DM * FFE;
            pg8::EpiPlain E{(bf16*)(ws + WS_Y), DM};
            pg8::gemm_phase<pg8::EpiPlain, MoeOrder, true, true, true>(ring, g, S, E);
        } else {
            pg8::Gemm g{(const bf16*)(ws + WS_XS), (const bf16*)(ws + WS_MW13), nT * 256, 2 * FFE, DM / 2, E8_W13, E8_ONE};
            MoeOrder S; S.so.init(nT * 256, 2 * FFE, C.G, (int)blockIdx.x); S.t0 = 0; S.tb1 = tb1; S.tb2 = tb2; S.tb3 = tb3; S.tb4 = tb4; S.tb5 = tb5; S.tb6 = tb6; S.tb7 = tb7; S.estride = (size_t)2 * FFE * DM;
            pg8::EpiSwiGlu8 E{ws + WS_HID0, FFE, MOE_HID_SCALE, MOE_HID_MAX};
            pg8::gemm_phase<pg8::EpiSwiGlu8, MoeOrder, true, true, true>(ring, g, S, E);
        }
    } else if constexpr (PH == PH_FIN) {
        final_rows(C, (const bf16*)out, out, as_global(in[25]), ws);
    }
}
template <int PH> __global__ void __launch_bounds__(NWAVES * 64, 2) phase_kernel(Args args) {
    extern __shared__ __attribute__((aligned(16))) unsigned char lds_raw[];
    for (int u = threadIdx.x; u < (LDS_BYTES - LDSCTL_OFF) / 4; u += NWAVES * 64) ((LAS unsigned*)((LAS unsigned char*)lds_raw + LDSCTL_OFF))[u] = 0u;
    __syncthreads();
    run_phase<PH>(lds_raw, args.in, args.out, args.ws, args.l, args.p);
}
#ifndef DBG_TIME
#define DBG_TIME 0
#define DBG_T1 1
#define DBG_T1N 1
#define DBG_T2 2
#define DBG_T2N 1
#endif
#ifndef DBG_CP
#define DBG_CP 0
#endif
#define CHECKPOINT(id) do { if (DBG_CP == (id)) { \
        const unsigned* src_ = (DBG_SUM_OFF == 9999) ? (const unsigned*)out : (const unsigned*)(ws + (size_t)DBG_SUM_OFF * MiB); unsigned acc_ = 0u; \
        for (size_t i = (size_t)blockIdx.x * 512 + threadIdx.x; i < (size_t)DBG_SUM_BYTES / 4; i += (size_t)gridDim.x * 512) acc_ += (src_[i] & DBG_SUM_MASK) * (unsigned)(2654435761u + 2u * (unsigned)(i & 1023u)); \
        _Pragma("unroll") for (int o = 1; o < 64; o <<= 1) acc_ += __shfl_xor(acc_, o); \
        if ((threadIdx.x & 63) == 0) atomicAdd((unsigned*)(ctl + 16), acc_); \
        xcd_barrier(bar); \
        const unsigned tot_ = __hip_atomic_load((unsigned*)(ctl + 16), __ATOMIC_RELAXED, __HIP_MEMORY_SCOPE_AGENT); \
        xcd_barrier(bar); \
        for (size_t i = (size_t)blockIdx.x * 512 + threadIdx.x; i < (size_t)NTOK * DM; i += (size_t)gridDim.x * 512) out[i] = (float)((tot_ >> (i & 15)) & 0xffu) * (1.0f / 256.0f) + 0.25f; \
        return; } } while (0)
__global__ void __launch_bounds__(NWAVES * 64, 2) mega_fwd(Args args) {
    extern __shared__ __attribute__((aligned(16))) unsigned char lds_raw[];
    for (int u = threadIdx.x; u < (LDS_BYTES - LDSCTL_OFF) / 4; u += NWAVES * 64) ((LAS unsigned*)((LAS unsigned char*)lds_raw + LDSCTL_OFF))[u] = 0u;
    __syncthreads();
    unsigned char* ws = args.ws;
    gu32* ctl = (gu32*)(ws + WS_CTL);
    volatile LAS unsigned* MISC = (volatile LAS unsigned*)((LAS unsigned char*)lds_raw + MISC_OFF);
    const XcdBarrier bar = xcd_barrier_post((unsigned*)(ctl + CW_BAR), MISC + 8);
    const float* const* in = args.in; float* out = args.out;
#ifndef DBG_REP_PH
#define DBG_REP_PH -1
#define DBG_REP_L 0
#define DBG_REP_P 0
#define DBG_REP_N 0
#endif
#define PHASE(PH, l_, p_) do { constexpr int nrep_ = ((PH) == DBG_REP_PH && (l_) == DBG_REP_L && (p_) == DBG_REP_P) ? 1 + DBG_REP_N : 1; \
        for (int rep_ = 0; rep_ < nrep_; ++rep_) { run_phase<PH>(lds_raw, in, out, ws, (l_), (p_)); if (rep_ + 1 < nrep_) xcd_barrier(bar); } } while (0)
#if DBG_TIME
#define SEAM do { xcd_barrier(bar); if (blockIdx.x == 0 && threadIdx.x == 0) { ((unsigned long long*)(ctl + 2048))[seam_i] = __builtin_amdgcn_s_memrealtime(); } ++seam_i; } while (0)
    int seam_i = 1;
    if (blockIdx.x == 0 && threadIdx.x == 0) ((unsigned long long*)(ctl + 2048))[0] = __builtin_amdgcn_s_memrealtime();
#else
#define SEAM xcd_barrier(bar)
#endif
    PHASE(PH_P0, 0, 0); SEAM;
    PHASE(PH_A, 0, 0); SEAM; CHECKPOINT(1); PHASE(PH_B, 0, 0); SEAM; CHECKPOINT(2);

    PHASE(PH_C, 0, 0); SEAM; CHECKPOINT(3); PHASE(PH_D, 0, 0); SEAM; CHECKPOINT(4); PHASE(PH_E, 0, 0); SEAM; CHECKPOINT(5); PHASE(PH_F, 0, 0); SEAM; CHECKPOINT(6);
    PHASE(PH_FUP, 0, 0); SEAM; CHECKPOINT(8); PHASE(PH_FDN, 0, 0); SEAM; CHECKPOINT(9);
    PHASE(PH_A, 1, 0); SEAM; PHASE(PH_B, 1, 0); SEAM; PHASE(PH_C, 1, 0); SEAM; PHASE(PH_D, 1, 0); SEAM; PHASE(PH_E, 1, 0); SEAM; PHASE(PH_F, 1, 0); SEAM;
    PHASE(PH_R1, 1, 0); SEAM; PHASE(PH_R2, 1, 0); SEAM;
    PHASE(PH_MOE, 1, 0); SEAM; PHASE(PH_MOE, 1, 1); SEAM;
    PHASE(PH_FIN, 1, 0);
#if DBG_TIME
    SEAM; SEAM;
    {
        const unsigned long long* T = (const unsigned long long*)(ctl + 2048);
        const unsigned long long a0 = __hip_atomic_load(T + DBG_T1 - 1, __ATOMIC_RELAXED, __HIP_MEMORY_SCOPE_AGENT), a1 = __hip_atomic_load(T + DBG_T1 + DBG_T1N - 1, __ATOMIC_RELAXED, __HIP_MEMORY_SCOPE_AGENT);
        const unsigned long long b0 = __hip_atomic_load(T + DBG_T2 - 1, __ATOMIC_RELAXED, __HIP_MEMORY_SCOPE_AGENT), b1 = __hip_atomic_load(T + DBG_T2 + DBG_T2N - 1, __ATOMIC_RELAXED, __HIP_MEMORY_SCOPE_AGENT);
        const float t1 = (float)(a1 - a0) * 0.01f, t2 = (float)(b1 - b0) * 0.01f; const float cval = sqrtf(t1 * 0.1f);
        for (size_t i = (size_t)blockIdx.x * 512 + threadIdx.x; i < (size_t)NTOK * DM; i += (size_t)gridDim.x * 512) out[i] = (i == 0) ? (t2 + 100.0f) : cval;
    }
#endif
#undef PHASE
#undef SEAM
}

template <int PH> static void launch_phase(const Args& a, int l, int p, int grid, hipStream_t stream) {
    static bool attr_set = false;
    if (!attr_set) { (void)hipFuncSetAttribute((const void*)phase_kernel<PH>, hipFuncAttributeMaxDynamicSharedMemorySize, LDS_BYTES); attr_set = true; }
    Args b = a; b.l = l; b.p = p;
    hipLaunchKernelGGL(phase_kernel<PH>, dim3(grid), dim3(NWAVES * 64), LDS_BYTES, stream, b);
}
extern "C" void kernel_launch(void* const* d_in, const int* in_sizes, int n_in, void* d_out, int out_size, void* d_ws, size_t ws_size, hipStream_t stream) {
    static int grid = 0;
    if (grid == 0) {
        if (n_in != 26 || in_sizes[0] != NTOK * DM || out_size != NTOK * DM || ws_size < WS_END) { fprintf(stderr, "kernel_launch: unexpected shapes (n_in %d, in0 %d, out %d, ws %zu); nothing launched\n", n_in, n_in > 0 ? in_sizes[0] : -1, out_size, ws_size); grid = -1; return; }
        int dev = 0, cus = 0, per_cu = 0;
        if (hipGetDevice(&dev) != hipSuccess || hipDeviceGetAttribute(&cus, hipDeviceAttributeMultiprocessorCount, dev) != hipSuccess) { grid = -1; return; }
        if (hipFuncSetAttribute((const void*)mega_fwd, hipFuncAttributeMaxDynamicSharedMemorySize, LDS_BYTES) != hipSuccess) { fprintf(stderr, "kernel_launch: hipFuncSetAttribute failed\n"); grid = -1; return; }
        if (hipOccupancyMaxActiveBlocksPerMultiprocessor(&per_cu, (const void*)mega_fwd, NWAVES * 64, LDS_BYTES) != hipSuccess || per_cu < 1)
            fprintf(stderr, "kernel_launch: note: occupancy query reports %d workgroups per CU\n", per_cu);
        (void)hipGetLastError();
        grid = cus;
        if (grid != 256) { fprintf(stderr, "kernel_launch: %d CUs; this kernel is laid out for 256\n", cus); grid = 256; }
    }
    if (grid < 0) return;
    if (hipMemsetAsync((char*)d_ws + WS_CTL, 0, CTL_ZERO_BYTES, stream) != hipSuccess) return;
    Args a{};
    for (int i = 0; i < 26; ++i) a.in[i] = (const float*)d_in[i];
    a.out = (float*)d_out; a.ws = (unsigned char*)d_ws; a.l = 0; a.p = 0;
#if MK_SPLIT
    launch_phase<PH_P0>(a, 0, 0, grid, stream);
    for (int l = 0; l < 2; ++l) {
        launch_phase<PH_A>(a, l, 0, grid, stream); launch_phase<PH_B>(a, l, 0, grid, stream); launch_phase<PH_C>(a, l, 0, grid, stream);
        launch_phase<PH_D>(a, l, 0, grid, stream); launch_phase<PH_E>(a, l, 0, grid, stream); launch_phase<PH_F>(a, l, 0, grid, stream);
        if (l == 0) { launch_phase<PH_FUP>(a, 0, 0, grid, stream); launch_phase<PH_FDN>(a, 0, 0, grid, stream); }
        else { launch_phase<PH_R1>(a, 1, 0, grid, stream); launch_phase<PH_R2>(a, 1, 0, grid, stream);
            for (int p = 0; p <= MOE_NCHUNK; ++p) launch_phase<PH_MOE>(a, 1, p, grid, stream);
            launch_phase<PH_FIN>(a, 1, 0, grid, stream); }
    }
#else
    hipLaunchKernelGGL(mega_fwd, dim3(grid), dim3(NWAVES * 64), LDS_BYTES, stream, a);
#endif
    const hipError_t le = hipPeekAtLastError();
    if (le != hipSuccess) fprintf(stderr, "kernel_launch: launch failed: %s\n", hipGetErrorName(le));
}
```

```cpp
#include <hip/hip_runtime.h>
#include <cstdio>
#include <cstdint>
namespace pg8 {
#define PG8_LAS __attribute__((address_space(3)))
typedef unsigned short bf16_t;
typedef short bf16x8 __attribute__((ext_vector_type(8)));
typedef float f32x4 __attribute__((ext_vector_type(4)));
typedef unsigned u32x4 __attribute__((ext_vector_type(4)));
constexpr int BM = 256, BK = 64, HALF = 128, HTB = HALF * BK * 2  , STAGE_BYTES = 8 * HTB, NXCD = 8, WGM = 8;

__host__ __device__ __forceinline__ int lds_byte(int r, int c) { const int st = (r >> 4) * 2 + (c >> 5), rr = r & 15, cc = c & 31, ob = rr * 64 + cc * 2; return st * 1024 + (ob ^ (((ob >> 9) & 1) << 5)); }
__host__ __device__ __forceinline__ void stage_rc(int b, int& R, int& C) { const int st = b / 1024, sb = b % 1024, swz = sb ^ (((sb >> 9) & 1) << 5); R = (st >> 1) * 16 + swz / 64; C = (st & 1) * 32 + (swz % 64) / 2; }
__host__ __device__ __forceinline__ int perm32(int rho) { const int n = rho >> 4, i = rho & 15; return 8 * (i >> 2) + 4 * n + (i & 3); }

struct Unit { int pm, pn; size_t boff; };
struct Gemm { const bf16_t* A; const bf16_t* Bt; int M, N, K; int sw, sa; };
typedef int pg8_v8i __attribute__((ext_vector_type(8))); typedef int pg8_v4i __attribute__((ext_vector_type(4)));
__device__ __forceinline__ pg8_v8i pg8_cat(bf16x8 lo, bf16x8 hi) { return __builtin_shufflevector(__builtin_bit_cast(pg8_v4i, lo), __builtin_bit_cast(pg8_v4i, hi), 0, 1, 2, 3, 4, 5, 6, 7); }

struct StaticOrder {
    int nM, nN, nwg, G, c;
    __host__ __device__ void init(int M, int N, int G_, int c_) { nM = M / BM; nN = N / BM; nwg = nM * nN; G = G_; c = c_; }
    __host__ __device__ bool next(int i, Unit& u) const {
        const long L = (long)i * G + c; if (L >= nwg) return false;
        int wgid = (int)L; { const int q = nwg / NXCD, r = nwg % NXCD, xcd = wgid % NXCD, off = wgid / NXCD; wgid = (xcd < r ? xcd * (q + 1) : r * (q + 1) + (xcd - r) * q) + off; }
        const int nig = WGM * nN, gid = wgid / nig, fm = gid * WGM, gsz = (nM - fm) < WGM ? (nM - fm) : WGM;
        u.pm = fm + ((wgid % nig) % gsz); u.pn = (wgid % nig) / gsz; u.boff = 0; return true;
    }
    __device__ __forceinline__ void a_ready(const Unit&) const {}
    __device__ __forceinline__ void done(const Unit&) const {}
};

typedef float f32x2c_t __attribute__((ext_vector_type(2))); typedef __bf16 bf16x2c_t __attribute__((ext_vector_type(2)));
__device__ __forceinline__ unsigned cvt_pk_bf16(float lo, float hi) { const f32x2c_t v = {lo, hi}; const bf16x2c_t b = __builtin_convertvector(v, bf16x2c_t); return __builtin_bit_cast(unsigned, b); }
typedef float f32x2 __attribute__((ext_vector_type(2)));
__device__ __forceinline__ f32x2 gelu_pk(f32x2 v) {
    const f32x2 av = __builtin_elementwise_abs(v), d = av * 0.2316418882f + 1.0f;
    f32x2 t; t.x = __builtin_amdgcn_rcpf(d.x); t.y = __builtin_amdgcn_rcpf(d.y);
    f32x2 q = t * 0.5307027145f + (-0.7265760135f); q = q * t + 0.7107068705f; q = q * t + (-0.142248368f); q = q * t + 0.127414796f; q = q * t;
    const f32x2 s = (v * v) * (-0.72134752044f);
    f32x2 e; e.x = __builtin_amdgcn_exp2f(s.x); e.y = __builtin_amdgcn_exp2f(s.y);
    const f32x2 m = v * (q * e), r = v - m;
    f32x2 o; o.x = v.x < 0.f ? m.x : r.x; o.y = v.y < 0.f ? m.y : r.y; return o;
}

template <int ACT  > struct EpiBf16 {
    static constexpr bool PERM = true, AFTER_DRAIN = false; static_assert(ACT == 0 || ACT == 1, "EpiBf16: ACT is 0 (none) or 1 (gelu_pk)");
    bf16_t* O; int ldc; const float* bias; int split_cols; size_t split_stride; float scale0;
    __device__ __forceinline__ void operator()(const f32x4 (&acc)[2][2][4][2], const Unit& u, int wr, int wc, int fr, int fq) const {
        const int row0 = u.pm * BM + wr * 64 + fr; int colt = u.pn * BM; bf16_t* base = O;
        float sc = 1.f; if (split_cols) { const int t = colt / split_cols; base += (size_t)t * split_stride; colt -= t * split_cols; if (t == 0) sc = scale0; }
        const int col0 = colt + wc * 32 + 8 * fq, bcol0 = u.pn * BM + wc * 32 + 8 * fq;
        f32x4 bv[2][2];
#pragma unroll
        for (int bj = 0; bj < 2; ++bj)
#pragma unroll
            for (int n = 0; n < 2; ++n) bv[bj][n] = bias ? *(const f32x4*)(bias + bcol0 + bj * HALF + 4 * n) : (f32x4){0.f, 0.f, 0.f, 0.f};
#pragma unroll
        for (int ai = 0; ai < 2; ++ai)
#pragma unroll
            for (int m = 0; m < 4; ++m) { bf16_t* rowp = base + (size_t)(row0 + ai * HALF + m * 16) * ldc + col0;
#pragma unroll
                for (int bj = 0; bj < 2; ++bj) { f32x4 v0 = acc[ai][bj][m][0] + bv[bj][0], v1 = acc[ai][bj][m][1] + bv[bj][1];
                    if (ACT == 1) { f32x2 a = gelu_pk((f32x2){v0[0], v0[1]}), b = gelu_pk((f32x2){v0[2], v0[3]}), c = gelu_pk((f32x2){v1[0], v1[1]}), d = gelu_pk((f32x2){v1[2], v1[3]});
                        v0 = (f32x4){a.x, a.y, b.x, b.y}; v1 = (f32x4){c.x, c.y, d.x, d.y}; }
                    v0 = v0 * sc; v1 = v1 * sc; u32x4 w; w.x = cvt_pk_bf16(v0[0], v0[1]); w.y = cvt_pk_bf16(v0[2], v0[3]); w.z = cvt_pk_bf16(v1[0], v1[1]); w.w = cvt_pk_bf16(v1[2], v1[3]);
                    *(u32x4*)(rowp + bj * HALF) = w; } }
    }
};

__device__ __forceinline__ float sigm(float x) { return __builtin_amdgcn_rcpf(1.0f + __builtin_amdgcn_exp2f(-1.4426950408889634f * x)); }
__device__ __forceinline__ float bflo(unsigned w) { return __uint_as_float(w << 16); }
__device__ __forceinline__ float bfhi(unsigned w) { return __uint_as_float(w & 0xffff0000u); }
__device__ __forceinline__ unsigned pk4_fp8(float a, float b, float c, float d) { unsigned w = 0u; w = __builtin_amdgcn_cvt_pk_fp8_f32(a, b, w, false); w = __builtin_amdgcn_cvt_pk_fp8_f32(c, d, w, true); return w; }
__device__ __forceinline__ void st8(bf16_t* p, f32x4 v0, f32x4 v1) { u32x4 w; w.x = cvt_pk_bf16(v0[0], v0[1]); w.y = cvt_pk_bf16(v0[2], v0[3]); w.z = cvt_pk_bf16(v1[0], v1[1]); w.w = cvt_pk_bf16(v1[2], v1[3]); *(u32x4*)p = w; }
__device__ __forceinline__ void ld8(const bf16_t* p, f32x4& v0, f32x4& v1) { const u32x4 w = *(const u32x4*)p; v0 = (f32x4){bflo(w.x), bfhi(w.x), bflo(w.y), bfhi(w.y)}; v1 = (f32x4){bflo(w.z), bfhi(w.z), bflo(w.w), bfhi(w.w)}; }

__device__ __forceinline__ float row_rstd(const unsigned long long* ss, int row) { return 1.0f / sqrtf((float)ss[row] * (1.0f / (16777216.0f * 1024.0f)) + 1e-6f); }
__device__ __forceinline__ float rstd_of(unsigned long long v) { return __builtin_amdgcn_rsqf((float)v * (1.0f / (16777216.0f * 1024.0f)) + 1e-6f); }
struct EpiProj { static constexpr bool PERM = true, AFTER_DRAIN = false, HAS_MID = false;
    bf16_t *Q, *Kp, *Vp, *U; float qscale; const unsigned long long* ss; int pn0; float s8q, s8kv;
    __device__ __forceinline__ void operator()(const f32x4 (&acc)[2][2][4][2], const Unit& u, int wr, int wc, int fr, int fq) const {
        const int row0 = u.pm * BM + wr * 64 + fr; const int pn = u.pn + pn0;
        bf16_t* base; int ldc, colt; float sc = 1.f;
        if (pn < 6) { base = Q; ldc = 1536; colt = pn * 256; sc = qscale; } else if (pn < 12) { base = Kp; ldc = 1536; colt = (pn - 6) * 256; }
        else if (pn < 18) { base = Vp; ldc = 1536; colt = (pn - 12) * 256; } else { base = U; ldc = 512; colt = (pn - 18) * 256; }
        const int col0 = colt + wc * 32 + 8 * fq;
        unsigned long long sv[2][4];
#pragma unroll
        for (int ai = 0; ai < 2; ++ai)
#pragma unroll
            for (int m = 0; m < 4; ++m) sv[ai][m] = ss[row0 + ai * HALF + m * 16];
        if (pn < 18) {
            unsigned char* base8 = (unsigned char*)base; const float s8v = sc * (pn < 6 ? s8q : s8kv);
            typedef unsigned u32x2p __attribute__((ext_vector_type(2)));
#pragma unroll
            for (int ai = 0; ai < 2; ++ai)
#pragma unroll
                for (int m = 0; m < 4; ++m) { const int row = row0 + ai * HALF + m * 16; unsigned char* rowp = base8 + (size_t)row * ldc + col0; const float rs = rstd_of(sv[ai][m]) * s8v;
#pragma unroll
                    for (int bj = 0; bj < 2; ++bj) { const f32x4 v0 = acc[ai][bj][m][0] * rs, v1 = acc[ai][bj][m][1] * rs; u32x2p w; w.x = pk4_fp8(v0[0], v0[1], v0[2], v0[3]); w.y = pk4_fp8(v1[0], v1[1], v1[2], v1[3]);
                        *(u32x2p*)(rowp + bj * HALF) = w; } }
            return; }
#pragma unroll
        for (int ai = 0; ai < 2; ++ai)
#pragma unroll
            for (int m = 0; m < 4; ++m) { const int row = row0 + ai * HALF + m * 16; bf16_t* rowp = base + (size_t)row * ldc + col0; const float rs = rstd_of(sv[ai][m]) * sc;
#pragma unroll
                for (int bj = 0; bj < 2; ++bj) st8(rowp + bj * HALF, acc[ai][bj][m][0] * rs, acc[ai][bj][m][1] * rs); }
    }
};
struct EpiSig { static constexpr bool PERM = true, AFTER_DRAIN = false, HAS_MID = false;
    bf16_t* O; int ldc; const unsigned long long* ss;
    __device__ __forceinline__ void operator()(const f32x4 (&acc)[2][2][4][2], const Unit& u, int wr, int wc, int fr, int fq) const {
        const int row0 = u.pm * BM + wr * 64 + fr, col0 = u.pn * BM + wc * 32 + 8 * fq;
        unsigned long long sv[2][4];
#pragma unroll
        for (int ai = 0; ai < 2; ++ai)
#pragma unroll
            for (int m = 0; m < 4; ++m) sv[ai][m] = ss[row0 + ai * HALF + m * 16];
#pragma unroll
        for (int ai = 0; ai < 2; ++ai)
#pragma unroll
            for (int m = 0; m < 4; ++m) { const int row = row0 + ai * HALF + m * 16; bf16_t* rowp = O + (size_t)row * ldc + col0; const float rs = rstd_of(sv[ai][m]);
#pragma unroll
                for (int bj = 0; bj < 2; ++bj) { f32x4 v0 = acc[ai][bj][m][0], v1 = acc[ai][bj][m][1];
#pragma unroll
                    for (int k = 0; k < 4; ++k) { v0[k] = sigm(v0[k] * rs); v1[k] = sigm(v1[k] * rs); }
                    st8(rowp + bj * HALF, v0, v1); } }
    }
};
struct EpiPlain { static constexpr bool PERM = true, AFTER_DRAIN = false, HAS_MID = false;
    bf16_t* O; int ldc;
    __device__ __forceinline__ void operator()(const f32x4 (&acc)[2][2][4][2], const Unit& u, int wr, int wc, int fr, int fq) const {
        asm volatile("" : "+v"(fr), "+v"(fq));
        const int row0 = u.pm * BM + wr * 64 + fr, col0 = u.pn * BM + wc * 32 + 8 * fq;
#pragma unroll
        for (int ai = 0; ai < 2; ++ai)
#pragma unroll
            for (int m = 0; m < 4; ++m) { bf16_t* rowp = O + (size_t)(row0 + ai * HALF + m * 16) * ldc + col0;
#pragma unroll
                for (int bj = 0; bj < 2; ++bj) st8(rowp + bj * HALF, acc[ai][bj][m][0], acc[ai][bj][m][1]); }
    }
};

struct EpiProbe { static constexpr bool PERM = true, AFTER_DRAIN = false, HAS_MID = false;
    bf16_t* O; int ldc; int live;
    __device__ __forceinline__ void operator()(const f32x4 (&acc)[2][2][4][2], const Unit& u, int wr, int wc, int fr, int fq) const {
        asm volatile("" : "+v"(fr), "+v"(fq));
        if (!live) { if (acc[0][0][0][0][0] == 1.2345e-30f && acc[1][1][3][1][3] == 3.3e-31f) O[0] = 0; return; }
        if (live == 4) {
            const int row0 = (int)blockIdx.x * BM + wr * 64 + fr, col0 = wc * 32 + 8 * fq;
#pragma unroll
            for (int ai = 0; ai < 2; ++ai)
#pragma unroll
                for (int m = 0; m < 4; ++m) { bf16_t* rowp = O + (size_t)(row0 + ai * HALF + m * 16) * 256 + col0;
#pragma unroll
                    for (int bj = 0; bj < 2; ++bj) st8(rowp + bj * HALF, acc[ai][bj][m][0], acc[ai][bj][m][1]); }
            return; }
        if (live >= 2) {
            const int lane = fq * 16 + fr, rsh = live == 2 ? 3 : 2, nr = 1 << rsh;
#pragma unroll
            for (int ai = 0; ai < 2; ++ai)
#pragma unroll
                for (int m = 0; m < 4; ++m)
#pragma unroll
                    for (int bj = 0; bj < 2; ++bj) { const int row = u.pm * BM + wr * 64 + ai * HALF + m * 16 + (live == 2 ? bj * 8 : bj * 4) + (lane & (nr - 1));
                        st8(O + (size_t)row * ldc + u.pn * BM + wc * 64 + (lane >> rsh) * 8, acc[ai][bj][m][0], acc[ai][bj][m][1]); }
            return; }
        const int row0 = u.pm * BM + wr * 64 + fr, col0 = u.pn * BM + wc * 32 + 8 * fq;
#pragma unroll
        for (int ai = 0; ai < 2; ++ai)
#pragma unroll
            for (int m = 0; m < 4; ++m) { bf16_t* rowp = O + (size_t)(row0 + ai * HALF + m * 16) * ldc + col0;
#pragma unroll
                for (int bj = 0; bj < 2; ++bj) st8(rowp + bj * HALF, acc[ai][bj][m][0], acc[ai][bj][m][1]); }
    }
};
struct EpiGlu { static constexpr bool PERM = true, AFTER_DRAIN = false, HAS_MID = false;
    const bf16_t* Zin; bf16_t* O; int ldc, ldo; const float* bias;
    __device__ __forceinline__ void operator()(const f32x4 (&acc)[2][2][4][2], const Unit& u, int wr, int wc, int fr, int fq) const {
        const int row0 = u.pm * BM + wr * 64 + fr, col0 = u.pn * BM + wc * 32 + 8 * fq;
        f32x4 bv[2][2];
#pragma unroll
        for (int bj = 0; bj < 2; ++bj)
#pragma unroll
            for (int n = 0; n < 2; ++n) bv[bj][n] = *(const f32x4*)(bias + col0 + bj * HALF + 4 * n);
#pragma unroll
        for (int ai = 0; ai < 2; ++ai) { u32x4 zw[4][2];
#pragma unroll
            for (int m = 0; m < 4; ++m)
#pragma unroll
                for (int bj = 0; bj < 2; ++bj) zw[m][bj] = *(const u32x4*)(Zin + (size_t)(row0 + ai * HALF + m * 16) * ldc + col0 + bj * HALF);
#pragma unroll
            for (int m = 0; m < 4; ++m) { const size_t offo = (size_t)(row0 + ai * HALF + m * 16) * ldo + col0;
#pragma unroll
                for (int bj = 0; bj < 2; ++bj) { const u32x4 w = zw[m][bj]; const f32x4 z0 = (f32x4){bflo(w.x), bfhi(w.x), bflo(w.y), bfhi(w.y)}, z1 = (f32x4){bflo(w.z), bfhi(w.z), bflo(w.w), bfhi(w.w)};
                    f32x4 v0 = acc[ai][bj][m][0] + bv[bj][0], v1 = acc[ai][bj][m][1] + bv[bj][1];
#pragma unroll
                    for (int k = 0; k < 4; ++k) { v0[k] = z0[k] * sigm(v0[k]); v1[k] = z1[k] * sigm(v1[k]); }
                    st8(O + offo + bj * HALF, v0, v1); } } }
    }
};
template <int MODE> struct EpiGate { static constexpr bool PERM = true, AFTER_DRAIN = false, HAS_MID = false;
    const bf16_t* G; int ldg, gcol0; bf16_t* O; int ldc;
    __device__ __forceinline__ void operator()(const f32x4 (&acc)[2][2][4][2], const Unit& u, int wr, int wc, int fr, int fq) const {
        const int row0 = u.pm * BM + wr * 64 + fr, col0 = u.pn * BM + wc * 32 + 8 * fq;
#pragma unroll
        for (int ai = 0; ai < 2; ++ai)
#pragma unroll
            for (int m = 0; m < 4; ++m) { const int row = row0 + ai * HALF + m * 16; const bf16_t* gp = G + (size_t)row * ldg + gcol0 + col0; bf16_t* op = O + (size_t)row * ldc + col0;
#pragma unroll
                for (int bj = 0; bj < 2; ++bj) { f32x4 g0, g1; ld8(gp + bj * HALF, g0, g1);
                    f32x4 v0 = acc[ai][bj][m][0] * g0, v1 = acc[ai][bj][m][1] * g1;
                    if (MODE == 1) { f32x4 p0, p1; ld8(op + bj * HALF, p0, p1); v0 = v0 + p0; v1 = v1 + p1; }
                    st8(op + bj * HALF, v0, v1); } }
    }
};
struct EpiResid { static constexpr bool PERM = false, AFTER_DRAIN = false, HAS_MID = false;
    const float* base; float* out; int ldc;
    __device__ __forceinline__ void operator()(const f32x4 (&acc)[2][2][4][2], const Unit& u, int wr, int wc, int fr, int fq) const {
        const int row0 = u.pm * BM + wr * 64 + fr, col0 = u.pn * BM + wc * 32 + 4 * fq;
#pragma unroll
        for (int ai = 0; ai < 2; ++ai) { f32x4 bv[4][2][2];
#pragma unroll
            for (int m = 0; m < 4; ++m)
#pragma unroll
                for (int bj = 0; bj < 2; ++bj)
#pragma unroll
                    for (int n = 0; n < 2; ++n) bv[m][bj][n] = *(const f32x4*)(base + (size_t)(row0 + ai * HALF + m * 16) * ldc + col0 + bj * HALF + n * 16);
#pragma unroll
            for (int m = 0; m < 4; ++m) { const size_t off = (size_t)(row0 + ai * HALF + m * 16) * ldc + col0;
#pragma unroll
                for (int bj = 0; bj < 2; ++bj)
#pragma unroll
                    for (int n = 0; n < 2; ++n) *(f32x4*)(out + off + bj * HALF + n * 16) = bv[m][bj][n] + acc[ai][bj][m][n]; } }
    }
};
template <bool NORM> struct EpiResidB { static constexpr bool PERM = true, AFTER_DRAIN = false, HAS_MID = false;
    const bf16_t* Xi; int ldi; bf16_t* X; int ldc; unsigned long long* ss; unsigned char* X8;
    __device__ __forceinline__ void operator()(const f32x4 (&acc)[2][2][4][2], const Unit& u, int wr, int wc, int fr, int fq) const {
        asm volatile("" : "+v"(fr), "+v"(fq));
        const int row0 = u.pm * BM + wr * 64 + fr, col0 = u.pn * BM + wc * 32 + 8 * fq;
        u32x4 xw[2][4][2];
#pragma unroll
        for (int ai = 0; ai < 2; ++ai)
#pragma unroll
            for (int m = 0; m < 4; ++m)
#pragma unroll
                for (int bj = 0; bj < 2; ++bj) xw[ai][m][bj] = *(const u32x4*)(Xi + (size_t)(row0 + ai * HALF + m * 16) * ldi + col0 + bj * HALF);
#pragma unroll
        for (int ai = 0; ai < 2; ++ai)
#pragma unroll
            for (int m = 0; m < 4; ++m) { const int row = row0 + ai * HALF + m * 16; bf16_t* op = X + (size_t)row * ldc + col0; float sq = 0.f;
#pragma unroll
                for (int bj = 0; bj < 2; ++bj) { const u32x4 w = xw[ai][m][bj];
                    const f32x4 v0 = (f32x4){bflo(w.x), bfhi(w.x), bflo(w.y), bfhi(w.y)} + acc[ai][bj][m][0], v1 = (f32x4){bflo(w.z), bfhi(w.z), bflo(w.w), bfhi(w.w)} + acc[ai][bj][m][1];
                    st8(op + bj * HALF, v0, v1);
                    if (X8) { typedef unsigned u32x2r __attribute__((ext_vector_type(2))); u32x2r w8; w8.x = pk4_fp8(v0[0] * 4.0f, v0[1] * 4.0f, v0[2] * 4.0f, v0[3] * 4.0f); w8.y = pk4_fp8(v1[0] * 4.0f, v1[1] * 4.0f, v1[2] * 4.0f, v1[3] * 4.0f);
                        *(u32x2r*)(X8 + (size_t)row * 1024 + col0 + bj * HALF) = w8; }
                    if (NORM) sq += ((v0[0] * v0[0] + v0[1] * v0[1]) + (v0[2] * v0[2] + v0[3] * v0[3])) + ((v1[0] * v1[0] + v1[1] * v1[1]) + (v1[2] * v1[2] + v1[3] * v1[3])); }
                if (NORM) { sq += __shfl_xor(sq, 16); sq += __shfl_xor(sq, 32);
                    if (fq == 0) __hip_atomic_fetch_add(ss + row, (unsigned long long)(sq * 16777216.0f), __ATOMIC_RELAXED, __HIP_MEMORY_SCOPE_AGENT); } }
    }
};
struct EpiSwiGlu { static constexpr bool PERM = true, AFTER_DRAIN = false, HAS_MID = false;
    bf16_t* H; int ldc; const unsigned long long* ss;
    __device__ __forceinline__ void operator()(const f32x4 (&acc)[2][2][4][2], const Unit& u, int wr, int wc, int fr, int fq) const {
        const int row0 = u.pm * BM + wr * 64 + fr, col0 = u.pn * HALF + wc * 32 + 8 * fq;
        unsigned long long sv[2][4];
#pragma unroll
        for (int ai = 0; ai < 2; ++ai)
#pragma unroll
            for (int m = 0; m < 4; ++m) sv[ai][m] = ss[row0 + ai * HALF + m * 16];
#pragma unroll
        for (int ai = 0; ai < 2; ++ai)
#pragma unroll
            for (int m = 0; m < 4; ++m) { const int row = row0 + ai * HALF + m * 16; const float rs = rstd_of(sv[ai][m]);
                f32x4 v0 = acc[ai][0][m][0] * rs, v1 = acc[ai][0][m][1] * rs; const f32x4 u0 = acc[ai][1][m][0] * rs, u1 = acc[ai][1][m][1] * rs;
#pragma unroll
                for (int k = 0; k < 4; ++k) { v0[k] = v0[k] * sigm(v0[k]) * u0[k]; v1[k] = v1[k] * sigm(v1[k]) * u1[k]; }
                st8(H + (size_t)row * ldc + col0, v0, v1); }
    }
};

struct EpiGateMid { static constexpr bool PERM = true, AFTER_DRAIN = false, HAS_MID = true;
    const bf16_t* G; int ldg, gs0; bf16_t* O; int ldc;
    __device__ __forceinline__ void mid(f32x4 (&acc)[2][2][4][2], const Unit& u, int wr, int wc, int fr, int fq) const {
        asm volatile("" : "+v"(fr), "+v"(fq));
        const int row0 = u.pm * BM + wr * 64 + fr, col0 = u.pn * BM + wc * 32 + 8 * fq;
#pragma unroll
        for (int ai = 0; ai < 2; ++ai)
#pragma unroll
            for (int mp = 0; mp < 2; ++mp) {
                u32x4 ga[2][2], gs[2][2];
#pragma unroll
                for (int mm = 0; mm < 2; ++mm)
#pragma unroll
                    for (int bj = 0; bj < 2; ++bj) { const bf16_t* gp = G + (size_t)(row0 + ai * HALF + (2 * mp + mm) * 16) * ldg + col0 + bj * HALF; ga[mm][bj] = *(const u32x4*)gp; gs[mm][bj] = *(const u32x4*)(gp + gs0); }
#pragma unroll
                for (int mm = 0; mm < 2; ++mm)
#pragma unroll
                    for (int bj = 0; bj < 2; ++bj) { const int m = 2 * mp + mm; const u32x4 a = ga[mm][bj], s = gs[mm][bj];
                        const f32x4 a0 = (f32x4){bflo(a.x), bfhi(a.x), bflo(a.y), bfhi(a.y)}, a1 = (f32x4){bflo(a.z), bfhi(a.z), bflo(a.w), bfhi(a.w)};
                        const f32x4 s0 = (f32x4){bflo(s.x), bfhi(s.x), bflo(s.y), bfhi(s.y)}, s1 = (f32x4){bflo(s.z), bfhi(s.z), bflo(s.w), bfhi(s.w)};
#pragma unroll
                        for (int k = 0; k < 4; ++k) { acc[ai][bj][m][0][k] *= a0[k] * __builtin_amdgcn_rcpf(s0[k]); acc[ai][bj][m][1][k] *= a1[k] * __builtin_amdgcn_rcpf(s1[k]); } }
                asm volatile("" : "+v"(acc[ai][0][2 * mp][0]), "+v"(acc[ai][0][2 * mp][1]), "+v"(acc[ai][1][2 * mp][0]), "+v"(acc[ai][1][2 * mp][1]), "+v"(acc[ai][0][2 * mp + 1][0]), "+v"(acc[ai][0][2 * mp + 1][1]), "+v"(acc[ai][1][2 * mp + 1][0]), "+v"(acc[ai][1][2 * mp + 1][1]) :: "memory"); }
    }
    __device__ __forceinline__ void operator()(const f32x4 (&acc)[2][2][4][2], const Unit& u, int wr, int wc, int fr, int fq) const {
        asm volatile("" : "+v"(fr), "+v"(fq));
        const int row0 = u.pm * BM + wr * 64 + fr, col0 = u.pn * BM + wc * 32 + 8 * fq;
        u32x4 gw[2][4][2];
#pragma unroll
        for (int ai = 0; ai < 2; ++ai)
#pragma unroll
            for (int m = 0; m < 4; ++m)
#pragma unroll
                for (int bj = 0; bj < 2; ++bj) gw[ai][m][bj] = *(const u32x4*)(G + (size_t)(row0 + ai * HALF + m * 16) * ldg + gs0 + col0 + bj * HALF);
#pragma unroll
        for (int ai = 0; ai < 2; ++ai)
#pragma unroll
            for (int m = 0; m < 4; ++m) { bf16_t* op = O + (size_t)(row0 + ai * HALF + m * 16) * ldc + col0;
#pragma unroll
                for (int bj = 0; bj < 2; ++bj) { const u32x4 w = gw[ai][m][bj]; const f32x4 s0 = (f32x4){bflo(w.x), bfhi(w.x), bflo(w.y), bfhi(w.y)}, s1 = (f32x4){bflo(w.z), bfhi(w.z), bflo(w.w), bfhi(w.w)};
                    st8(op + bj * HALF, acc[ai][bj][m][0] * s0, acc[ai][bj][m][1] * s1); } }
    }
};

struct EpiSwiGlu8 { static constexpr bool PERM = true, AFTER_DRAIN = false, HAS_MID = false;
    unsigned char* H; int ldc; float hs, hmax;
    __device__ __forceinline__ void operator()(const f32x4 (&acc)[2][2][4][2], const Unit& u, int wr, int wc, int fr, int fq) const {
        asm volatile("" : "+v"(fr), "+v"(fq));
        const int row0 = u.pm * BM + wr * 64 + fr, col0 = u.pn * HALF + wc * 32 + 8 * fq;
#pragma unroll
        for (int ai = 0; ai < 2; ++ai)
#pragma unroll
            for (int m = 0; m < 4; ++m) { f32x4 v0 = acc[ai][0][m][0], v1 = acc[ai][0][m][1]; const f32x4 u0 = acc[ai][1][m][0], u1 = acc[ai][1][m][1];
#pragma unroll
                for (int k = 0; k < 4; ++k) { v0[k] = fminf(fmaxf(v0[k] * sigm(v0[k]) * u0[k] * hs, -hmax), hmax); v1[k] = fminf(fmaxf(v1[k] * sigm(v1[k]) * u1[k] * hs, -hmax), hmax); }
                typedef unsigned u32x2 __attribute__((ext_vector_type(2)));
                u32x2 w; w.x = pk4_fp8(v0[0], v0[1], v0[2], v0[3]); w.y = pk4_fp8(v1[0], v1[1], v1[2], v1[3]);
                *(u32x2*)(H + (size_t)(row0 + ai * HALF + m * 16) * ldc + col0) = w; }
    }
};

struct EpiResidNorm { static constexpr bool PERM = false, AFTER_DRAIN = false, HAS_MID = false;
    const float* base; float* out; int ldc; bf16_t* Xb; unsigned long long* ss;
    __device__ __forceinline__ void operator()(const f32x4 (&acc)[2][2][4][2], const Unit& u, int wr, int wc, int fr, int fq) const {
        const int row0 = u.pm * BM + wr * 64 + fr, col0 = u.pn * BM + wc * 32 + 4 * fq;
        typedef unsigned u32x2e __attribute__((ext_vector_type(2)));
#pragma unroll
        for (int ai = 0; ai < 2; ++ai) { f32x4 bv[4][2][2];
#pragma unroll
            for (int m = 0; m < 4; ++m)
#pragma unroll
                for (int bj = 0; bj < 2; ++bj)
#pragma unroll
                    for (int n = 0; n < 2; ++n) bv[m][bj][n] = *(const f32x4*)(base + (size_t)(row0 + ai * HALF + m * 16) * ldc + col0 + bj * HALF + n * 16);
#pragma unroll
            for (int m = 0; m < 4; ++m) { const int row = row0 + ai * HALF + m * 16; const size_t off = (size_t)row * ldc + col0; float sq = 0.f;
#pragma unroll
                for (int bj = 0; bj < 2; ++bj)
#pragma unroll
                    for (int n = 0; n < 2; ++n) { const f32x4 x = bv[m][bj][n] + acc[ai][bj][m][n]; *(f32x4*)(out + off + bj * HALF + n * 16) = x;
                        u32x2e w; w.x = cvt_pk_bf16(x[0], x[1]); w.y = cvt_pk_bf16(x[2], x[3]); *(u32x2e*)(Xb + off + bj * HALF + n * 16) = w;
                        sq += (x[0] * x[0] + x[1] * x[1]) + (x[2] * x[2] + x[3] * x[3]); }
                sq += __shfl_xor(sq, 16); sq += __shfl_xor(sq, 32);
                if (fq == 0) __hip_atomic_fetch_add(ss + row, (unsigned long long)(sq * 16777216.0f), __ATOMIC_RELAXED, __HIP_MEMORY_SCOPE_AGENT); } }
    }
};
template <class Epi, class Sched, bool ALIGN_EPI = false, bool SP2 = false, bool FP8 = false>
__device__ __forceinline__ void gemm_phase(PG8_LAS unsigned char* lds, const Gemm g, const Sched& S, const Epi& E) {
    int tid_ = threadIdx.x; asm volatile("" : "+v"(tid_));
    const int tid = tid_, wid = __builtin_amdgcn_readfirstlane(tid >> 6), lane = tid & 63, wr = wid >> 2, wc = wid & 3, fr = lane & 15, fq = lane >> 4;
    const int K = g.K, nt = K / BK;
    int sw_v = g.sw, sa_v = g.sa; asm volatile("" : "+v"(sw_v), "+v"(sa_v));
    unsigned voffA[2], voffB[2];
#pragma unroll
    for (int i = 0; i < 2; ++i) { int R, C; stage_rc(tid * 16 + i * 8192, R, C); const int Rb = Epi::PERM ? ((R & ~31) + perm32(R & 31)) : R;
        voffA[i] = (unsigned)(R * K + C) * 2u; voffB[i] = (unsigned)(Rb * K + C) * 2u; }
    const size_t kstep = (size_t)(BK * 2);
    const size_t hstep = (size_t)HALF * K * 2;
    const size_t tstep = 2 * hstep;
    const unsigned ldsw = (unsigned)wid * 1024u;
    const int aoff = lds_byte(wr * 64 + fr, fq * 8), boff = lds_byte(wc * 32 + fr, fq * 8);
#define PG8_SA(b, h) (((b) * 2 + (h)) * HTB)
#define PG8_SB(b, h) ((4 + (b) * 2 + (h)) * HTB)
#define PG8_STAGE(bufoff, gbase, voff) do { _Pragma("unroll") for (int _i = 0; _i < 2; ++_i) \
        __builtin_amdgcn_global_load_lds((const unsigned*)((const char*)(gbase) + (voff)[_i]), (PG8_LAS unsigned*)(lds + (bufoff) + ldsw + _i * 8192), 16, 0, 0); } while (0)
#define PG8_LDA(dst, b, h) do { if constexpr (FP8) { _Pragma("unroll") for (int m = 0; m < 4; ++m) dst##8[m] = pg8_cat(*(const PG8_LAS bf16x8*)(lds + PG8_SA(b, h) + aoff + m * 2048), *(const PG8_LAS bf16x8*)(lds + PG8_SA(b, h) + aoff + m * 2048 + 1024)); } else { \
        _Pragma("unroll") for (int m = 0; m < 4; ++m) _Pragma("unroll") for (int k = 0; k < 2; ++k) dst[m][k] = *(const PG8_LAS bf16x8*)(lds + PG8_SA(b, h) + aoff + m * 2048 + k * 1024); } } while (0)
#define PG8_LDB(dst, b, h) do { if constexpr (FP8) { _Pragma("unroll") for (int n = 0; n < 2; ++n) dst##8[n] = pg8_cat(*(const PG8_LAS bf16x8*)(lds + PG8_SB(b, h) + boff + n * 2048), *(const PG8_LAS bf16x8*)(lds + PG8_SB(b, h) + boff + n * 2048 + 1024)); } else { \
        _Pragma("unroll") for (int n = 0; n < 2; ++n) _Pragma("unroll") for (int k = 0; k < 2; ++k) dst[n][k] = *(const PG8_LAS bf16x8*)(lds + PG8_SB(b, h) + boff + n * 2048 + k * 1024); } } while (0)
#define PG8_MMA(ai, bj, At, Bt) do { __builtin_amdgcn_s_setprio(1); if constexpr (FP8) { _Pragma("unroll") for (int m = 0; m < 4; ++m) _Pragma("unroll") for (int n = 0; n < 2; ++n) \
        asm volatile("v_mfma_scale_f32_16x16x128_f8f6f4 %0, %1, %2, %0, %3, %4 op_sel_hi:[0,0,0]" : "+v"(acc[ai][bj][m][n]) : "v"(Bt##8[n]), "v"(At##8[m]), "v"(sw_v), "v"(sa_v)); } else { \
        _Pragma("unroll") for (int m = 0; m < 4; ++m) _Pragma("unroll") for (int n = 0; n < 2; ++n) _Pragma("unroll") for (int k = 0; k < 2; ++k) \
        acc[ai][bj][m][n] = __builtin_amdgcn_mfma_f32_16x16x32_bf16(Bt[n][k], At[m][k], acc[ai][bj][m][n], 0, 0, 0); } __builtin_amdgcn_s_setprio(0); } while (0)
#define PG8_WAIT_V(n) asm volatile("s_waitcnt vmcnt(" #n ")" ::: "memory")
#define PG8_WAIT_L(n) asm volatile("s_waitcnt lgkmcnt(" #n ")" ::: "memory")
#define PG8_BAR __builtin_amdgcn_s_barrier()
#define PG8_SCHED __builtin_amdgcn_sched_barrier(0)
    Unit cur, nxt; int ui = 0;
    if (!S.next(0, cur)) return;
    f32x4 acc[2][2][4][2];
#pragma unroll
    for (int a = 0; a < 2; ++a)
#pragma unroll
        for (int b = 0; b < 2; ++b)
#pragma unroll
            for (int m = 0; m < 4; ++m)
#pragma unroll
                for (int n = 0; n < 2; ++n) acc[a][b][m][n] = (f32x4){0.f, 0.f, 0.f, 0.f};
    bf16x8 At[4][2], B0[2][2], B1[2][2];
    pg8_v8i At8[4], B08[2], B18[2];
    const char* cA = (const char*)g.A + (size_t)cur.pm * tstep; const char* cB = (const char*)g.Bt + cur.boff + (size_t)cur.pn * tstep;
    S.a_ready(cur);
    if constexpr (SP2) {
        PG8_STAGE(PG8_SB(0, 0), cB, voffB); PG8_STAGE(PG8_SB(0, 1), cB + hstep, voffB); PG8_STAGE(PG8_SA(0, 0), cA, voffA); PG8_STAGE(PG8_SA(0, 1), cA + hstep, voffA);
        if (wr == 1) PG8_BAR;
        PG8_WAIT_V(2); PG8_BAR;
        PG8_STAGE(PG8_SB(1, 0), cB + kstep, voffB); PG8_STAGE(PG8_SA(1, 0), cA + kstep, voffA); PG8_STAGE(PG8_SB(1, 1), cB + hstep + kstep, voffB);
        PG8_WAIT_V(6); PG8_BAR;
    } else {
        PG8_STAGE(PG8_SB(0, 0), cB, voffB); PG8_STAGE(PG8_SA(0, 0), cA, voffA); PG8_STAGE(PG8_SB(0, 1), cB + hstep, voffB); PG8_STAGE(PG8_SA(0, 1), cA + hstep, voffA);
        if (wr == 1) PG8_BAR;
        PG8_WAIT_V(4); PG8_BAR;
        PG8_STAGE(PG8_SB(1, 0), cB + kstep, voffB); PG8_STAGE(PG8_SA(1, 0), cA + kstep, voffA); PG8_STAGE(PG8_SB(1, 1), cB + hstep + kstep, voffB);
        PG8_WAIT_V(6); PG8_BAR;
    }
    for (;;) {
        const bool has_next = S.next(ui + 1, nxt);
        const char* nA = has_next ? (const char*)g.A + (size_t)nxt.pm * tstep : cA; const char* nB = has_next ? (const char*)g.Bt + nxt.boff + (size_t)nxt.pn * tstep : cB;
        _Pragma("nounroll")
        for (int t = 0; t < nt; t += 2) {
            if constexpr (Epi::HAS_MID) { if (t == nt / 2) E.mid(acc, cur, wr, wc, fr, fq); }
            const bool last = (t == nt - 2);
            const char* a1 = cA + (size_t)(t + 1) * kstep;
            const char* a2 = last ? nA : cA + (size_t)(t + 2) * kstep; const char* b2 = last ? nB : cB + (size_t)(t + 2) * kstep;
            const char* a3 = a2 + kstep; const char* b3 = b2 + kstep;
            if (last && has_next) S.a_ready(nxt);
            if constexpr (SP2) {
            PG8_LDB(B0, 0, 0); PG8_LDB(B1, 0, 1); PG8_SCHED; PG8_LDA(At, 0, 0); PG8_STAGE(PG8_SA(1, 1), a1 + hstep, voffA);
            PG8_WAIT_V(8); PG8_WAIT_L(0); PG8_BAR; PG8_MMA(0, 0, At, B0); PG8_MMA(0, 1, At, B1); PG8_BAR; PG8_SCHED;
            PG8_LDA(At, 0, 1); PG8_STAGE(PG8_SB(0, 0), b2, voffB); PG8_STAGE(PG8_SB(0, 1), b2 + hstep, voffB); PG8_STAGE(PG8_SA(0, 0), a2, voffA);
            PG8_WAIT_V(8); PG8_WAIT_L(0); PG8_BAR; PG8_MMA(1, 0, At, B0); PG8_MMA(1, 1, At, B1); PG8_BAR; PG8_SCHED;
            PG8_LDB(B0, 1, 0); PG8_LDB(B1, 1, 1); PG8_SCHED; PG8_LDA(At, 1, 0); PG8_STAGE(PG8_SA(0, 1), a2 + hstep, voffA);
            PG8_WAIT_V(8); PG8_WAIT_L(0); PG8_BAR; PG8_MMA(0, 0, At, B0); PG8_MMA(0, 1, At, B1); PG8_BAR; PG8_SCHED;
            PG8_LDA(At, 1, 1); PG8_STAGE(PG8_SB(1, 0), b3, voffB); PG8_STAGE(PG8_SB(1, 1), b3 + hstep, voffB); PG8_STAGE(PG8_SA(1, 0), a3, voffA);
            PG8_WAIT_V(8); PG8_WAIT_L(0); PG8_BAR; PG8_MMA(1, 0, At, B0); PG8_MMA(1, 1, At, B1); PG8_BAR; PG8_SCHED;
            } else {
            PG8_LDB(B0, 0, 0); PG8_SCHED; PG8_LDA(At, 0, 0); PG8_STAGE(PG8_SA(1, 1), a1 + hstep, voffA);
            PG8_WAIT_L(8); PG8_BAR; PG8_WAIT_L(0); PG8_MMA(0, 0, At, B0); PG8_BAR; PG8_SCHED;
            PG8_LDB(B1, 0, 1); PG8_STAGE(PG8_SB(0, 0), b2, voffB);
            PG8_BAR; PG8_WAIT_L(0); PG8_MMA(0, 1, At, B1); PG8_BAR;
            PG8_LDA(At, 0, 1); PG8_STAGE(PG8_SA(0, 0), a2, voffA);
            PG8_BAR; PG8_WAIT_L(0); PG8_MMA(1, 0, At, B0); PG8_BAR; PG8_SCHED;
            PG8_STAGE(PG8_SB(0, 1), b2 + hstep, voffB);
            PG8_WAIT_V(6); PG8_BAR; PG8_MMA(1, 1, At, B1); PG8_BAR;
            PG8_LDB(B0, 1, 0); PG8_SCHED; PG8_LDA(At, 1, 0); PG8_STAGE(PG8_SA(0, 1), a2 + hstep, voffA);
            PG8_WAIT_L(8); PG8_BAR; PG8_WAIT_L(0); PG8_MMA(0, 0, At, B0); PG8_BAR; PG8_SCHED;
            PG8_LDB(B1, 1, 1); PG8_STAGE(PG8_SB(1, 0), b3, voffB);
            PG8_BAR; PG8_WAIT_L(0); PG8_MMA(0, 1, At, B1); PG8_BAR;
            PG8_LDA(At, 1, 1); PG8_STAGE(PG8_SA(1, 0), a3, voffA);
            PG8_BAR; PG8_WAIT_L(0); PG8_MMA(1, 0, At, B0); PG8_BAR; PG8_SCHED;
            PG8_STAGE(PG8_SB(1, 1), b3 + hstep, voffB);
            PG8_WAIT_V(6); PG8_BAR; PG8_MMA(1, 1, At, B1); PG8_BAR;
            }
        }
        if constexpr (FP8) {
            _Pragma("unroll") for (int a_ = 0; a_ < 2; ++a_) _Pragma("unroll") for (int b_ = 0; b_ < 2; ++b_) asm volatile("s_nop 15" : "+v"(acc[a_][b_][0][0]), "+v"(acc[a_][b_][0][1]), "+v"(acc[a_][b_][1][0]), "+v"(acc[a_][b_][1][1]), "+v"(acc[a_][b_][2][0]), "+v"(acc[a_][b_][2][1]), "+v"(acc[a_][b_][3][0]), "+v"(acc[a_][b_][3][1])); }
        if constexpr (ALIGN_EPI) { if (wr == 0) PG8_BAR; }
        if constexpr (!Epi::AFTER_DRAIN) { E(acc, cur, wr, wc, fr, fq); S.done(cur); }
        if (!has_next) break;
#pragma unroll
        for (int a = 0; a < 2; ++a)
#pragma unroll
            for (int b = 0; b < 2; ++b)
#pragma unroll
                for (int m = 0; m < 4; ++m)
#pragma unroll
                    for (int n = 0; n < 2; ++n) acc[a][b][m][n] = (f32x4){0.f, 0.f, 0.f, 0.f};
        cur = nxt; cA = nA; cB = nB; ++ui;
        if constexpr (ALIGN_EPI) { if (wr == 1) PG8_BAR; }
    }
    PG8_WAIT_V(0);
    if constexpr (!ALIGN_EPI) { if (wr == 0) PG8_BAR; }
    PG8_BAR;
    if constexpr (Epi::AFTER_DRAIN) { E.fused(acc, cur, wr, wc, fr, fq, lds, wid, lane); S.done(cur); }
#undef PG8_SA
#undef PG8_SB
#undef PG8_STAGE
#undef PG8_LDA
#undef PG8_LDB
#undef PG8_MMA
#undef PG8_WAIT_V
#undef PG8_WAIT_L
#undef PG8_BAR
#undef PG8_SCHED
}
}

#define GAS __attribute__((address_space(1)))
#define LAS __attribute__((address_space(3)))
typedef unsigned short bf16;
typedef unsigned v4u __attribute__((ext_vector_type(4)));
typedef float f32x4 __attribute__((ext_vector_type(4)));
typedef short bf16x8 __attribute__((ext_vector_type(8)));
typedef GAS unsigned gu32;
typedef GAS unsigned long long gu64;
#define RLX_AGENT __ATOMIC_RELAXED, __HIP_MEMORY_SCOPE_AGENT
#define LDS_WAIT() asm volatile("s_waitcnt lgkmcnt(0)" ::: "memory")
#define VM_WAIT() asm volatile("s_waitcnt vmcnt(0)" ::: "memory")
__device__ __forceinline__ unsigned long long rt() { return __builtin_amdgcn_s_memrealtime(); }
__device__ __forceinline__ unsigned f2bf(float f) { unsigned u = __builtin_bit_cast(unsigned, f); return (u + 0x7fffu + ((u >> 16) & 1u)) >> 16; }
__device__ __forceinline__ unsigned pk2(float lo, float hi) { return f2bf(lo) | (f2bf(hi) << 16); }

#define XB_TMO      128
#define XB_XCNT(j)  (256  + 64 * (j))
#define XB_XSUB(j)  (1280 + 64 * (j))
#define XB_XGEN(j)  (2304 + 64 * (j))
#define XB_TOP      3328
#define XB_TOPGEN   3392
#define XCD_BAR_WORDS 3456
#define XB_SPIN_CAP (1u << 18)

__device__ __forceinline__ unsigned xb_ld(unsigned* p)              { return __hip_atomic_load(p, __ATOMIC_RELAXED, __HIP_MEMORY_SCOPE_AGENT); }
__device__ __forceinline__ unsigned xb_add(unsigned* p, unsigned v) { return __hip_atomic_fetch_add(p, v, __ATOMIC_RELAXED, __HIP_MEMORY_SCOPE_AGENT); }
__device__ __forceinline__ unsigned xb_xcc_id() { return (unsigned)__builtin_amdgcn_s_getreg((3 << 11) | 20) & 0xFu; }
#define XB_SPIN(cond, bar) do { unsigned _sp = 0; while (cond) { __builtin_amdgcn_s_sleep(1); \
    if ((++_sp & 255u) == 0u) { if (xb_ld(&(bar)[XB_TMO])) break; if (_sp > XB_SPIN_CAP) { atomicAdd(&(bar)[XB_TMO], 1u); break; } } } } while (0)

struct XcdBarrier {
    unsigned* bar; unsigned x;
    volatile LAS unsigned* st;
};

__device__ __forceinline__ XcdBarrier xcd_barrier_post(unsigned* bar, volatile LAS unsigned* st) {
    XcdBarrier b; b.bar = bar; b.x = xb_xcc_id(); b.st = st;
    if (threadIdx.x == 0) (void)xb_add(&bar[XB_XCNT(b.x)], 1u);
    return b;
}
__device__ __forceinline__ void xcd_barrier_complete(unsigned* bar, unsigned x, unsigned& nloc, unsigned& nx) {
    const unsigned G = gridDim.x * gridDim.y * gridDim.z;
    unsigned sum, cnt, mine, sp = 0u;
    for (;;) {
        sum = 0u; cnt = 0u; mine = 0u;
#pragma unroll
        for (unsigned j = 0; j < 16; ++j) { const unsigned c = xb_ld(&bar[XB_XCNT(j)]); sum += c; cnt += (c > 0u) ? 1u : 0u; mine = (j == x) ? c : mine; }
        if (sum == G) break;
        __builtin_amdgcn_s_sleep(1);
        if ((++sp & 255u) == 0u) { if (xb_ld(&bar[XB_TMO])) break; if (sp > XB_SPIN_CAP) { atomicAdd(&bar[XB_TMO], 1u); break; } }
    }
    nloc = mine > 0u ? mine : 1u; nx = cnt > 0u ? cnt : 1u;
}

__device__ __forceinline__ void xcd_barrier(const XcdBarrier& b) {
    asm volatile("s_waitcnt vmcnt(0)" ::: "memory");
    __syncthreads();
    if (threadIdx.x == 0) {
        unsigned* bar = b.bar;
        __builtin_amdgcn_s_waitcnt(0);
        unsigned nloc = b.st[0], nx = b.st[1];
        if (nloc == 0u) { xcd_barrier_complete(bar, b.x, nloc, nx); b.st[0] = nloc; b.st[1] = nx; }
        const unsigned old = xb_add(&bar[XB_XSUB(b.x)], 1u);
        const unsigned gen = old / nloc;
        if (old + 1u == (gen + 1u) * nloc) {
            __builtin_amdgcn_fence(__ATOMIC_RELEASE, "agent");
            asm volatile("s_waitcnt vmcnt(0)" ::: "memory");
            const unsigned og = xb_add(&bar[XB_TOP], 1u);
            const unsigned tg = og / nx;
            if (og + 1u == (tg + 1u) * nx) xb_add(&bar[XB_TOPGEN], 1u);
            else XB_SPIN(xb_ld(&bar[XB_TOPGEN]) == tg, bar);
            __builtin_amdgcn_fence(__ATOMIC_ACQUIRE, "agent");
            xb_add(&bar[XB_XGEN(b.x)], 1u);
            asm volatile("s_waitcnt vmcnt(0)" ::: "memory");
        } else {
            XB_SPIN(xb_ld(&bar[XB_XGEN(b.x)]) == gen, bar);
            __builtin_amdgcn_fence(__ATOMIC_ACQUIRE, "agent");
            asm volatile("s_waitcnt vmcnt(0)" ::: "memory");
        }
    }
    __syncthreads();
}

constexpr int NWAVES = 8;
constexpr int DM = 1024, BATCH = 2, SEQ = 16384, NTOK = BATCH * SEQ;
constexpr int AW = 1536, AOUT = 512, SW = 512, PW = 7168, NQKVU = 5120, NGATE = 2048;
constexpr int FF = 2816, FFE = 3584, NEXP = 8;
constexpr int SSM_G = 32, SSM_P = 64, SSM_C = 16, CHUNK = 128, NCHUNK = SEQ / CHUNK;
constexpr float EPS = 1e-6f;
constexpr float LOG2E = 1.4426950408889634f;
constexpr int MOE_ROWS = 2 * NTOK + NEXP * 256;
constexpr int MOE_NCHUNK = 1;
constexpr int N_PHASES = 26;

constexpr size_t MiB = 1u << 20, KiB = 1u << 10;
constexpr size_t WS_CTL = 0, CTL_ZERO_BYTES = 1 * MiB;
constexpr size_t TAB_BIAS = 1 * MiB;
constexpr size_t TAB_LAMB = 1 * MiB + 16 * KiB;
constexpr size_t TAB_BB   = 1 * MiB + 64 * KiB;
constexpr size_t TAB_CM   = 1 * MiB + 576 * KiB;
constexpr size_t TOK_E = 2 * MiB, TOK_R = TOK_E + 128 * KiB, TOK_G = TOK_R + 256 * KiB, TOK_S = TOK_G + 256 * KiB, CNTWG = TOK_S + 256 * KiB;
constexpr size_t WS_LSE = 4 * MiB;
constexpr size_t WS_E = 8 * MiB;
constexpr size_t WS_WS = 12 * MiB, WL_STRIDE = 18 * MiB + 512 * KiB;
constexpr size_t WL_QKVU = 0, WL_G = 10 * MiB, WL_GLU = 14 * MiB, WL_ABR = 14 * MiB + 512 * KiB, WL_SBR = 15 * MiB + 512 * KiB, WL_OUT = 16 * MiB + 512 * KiB;
constexpr size_t WS_W13 = WS_WS + 37 * MiB, WS_W2 = WS_WS + 48 * MiB;
constexpr size_t WS_H = 66 * MiB, WS_QP = 130 * MiB, WS_KP = 226 * MiB, WS_VP = 322 * MiB, WS_U = 418 * MiB, WS_Z = 450 * MiB, WS_AO = 482 * MiB;
constexpr size_t WS_G = WS_KP, WS_M = WS_QP, WS_ZG = WS_U, WS_HID = 130 * MiB;
constexpr size_t WS_MW13 = 12 * MiB, WS_MW2 = 68 * MiB, WS_XS = 96 * MiB, WS_Y = 162 * MiB, WS_HID0 = 294 * MiB, WS_END = 536 * MiB;
static_assert(WS_W2 + (size_t)DM * FF * 2 <= WS_H && WS_AO + (size_t)NTOK * 2 * AOUT * 2 <= 572 * MiB && WS_HID + (size_t)NTOK * FF * 2 <= WS_U, "ws map");
static_assert(WS_MW13 + (size_t)NEXP * 2 * FFE * DM == WS_MW2 && WS_MW2 + (size_t)NEXP * DM * FFE == WS_XS && WS_XS + (size_t)MOE_ROWS * DM == WS_Y && WS_Y + (size_t)MOE_ROWS * DM * 2 == WS_HID0 && WS_HID0 + (size_t)MOE_ROWS * FFE <= WS_END, "moe ws map");
constexpr float MOE_W13_SCALE = 32.0f, MOE_W2_SCALE = 64.0f, MOE_HID_SCALE = 8.0f, MOE_HID_MAX = 440.0f;
constexpr float QKV8_SQ = 64.0f, QKV8_SKV = 16.0f;
#ifndef QK_FP8
#define QK_FP8 1
#endif
constexpr int NQK = 4608;
constexpr size_t WL_VU_OFF = 5 * MiB;
#ifndef GATE_FP8
#define GATE_FP8 1
#endif
constexpr float X8_SCALE = 4.0f; constexpr int E8_X = 0x7d7d7d7d;
constexpr int E8_W13 = 0x7a7a7a7a, E8_W2 = 0x79797979, E8_HID = 0x7c7c7c7c, E8_ONE = 0x7f7f7f7f;
constexpr int CW_TMO = 0, CW_BAR = 4096;
constexpr size_t SS_P0 = 64 * KiB, SS_A = 320 * KiB, SS_B = 576 * KiB;
constexpr float SS_SCALE = 16777216.0f, SS_INV = 1.0f / (16777216.0f * 1024.0f);

constexpr int RING_BYTES = 131072, LDSCTL_OFF = RING_BYTES, MISC_OFF = LDSCTL_OFF + 320, LDS_BYTES = 147456;

template <class T> __device__ __forceinline__ T* as_global(T* p) { return (T*)(GAS T*)p; }
struct Ctx { LAS unsigned char* lds; int tid, lane, wave, vcu, G; };
typedef float f32x2v __attribute__((ext_vector_type(2)));
typedef int i32x2v __attribute__((ext_vector_type(2)));
typedef short v4i16_t __attribute__((ext_vector_type(4)));
__device__ __forceinline__ float wave_sum(float v) {
#pragma unroll
    for (int o = 1; o < 64; o <<= 1) v += __shfl_xor(v, o);
    return v;
}
__device__ __forceinline__ float bf2f(bf16 h) { return __uint_as_float((unsigned)h << 16); }
__device__ __forceinline__ float sigm_f(float x) { return __builtin_amdgcn_rcpf(1.0f + __builtin_amdgcn_exp2f(-LOG2E * x)); }
__device__ __forceinline__ unsigned cvtpk(float lo, float hi) { return pg8::cvt_pk_bf16(lo, hi); }

__device__ __forceinline__ void build_tables(const Ctx& C, const float* rel_bias, const float* lam_re, const float* lam_im, const float* log_dt,
                                             const float* b_re, const float* b_im, const float* c_re, const float* c_im, unsigned char* ws) {
    const int gt = C.vcu * 512 + C.tid, GT = C.G * 512;
    float* bt = (float*)(ws + TAB_BIAS);
    for (int i = gt; i < 3 * 8 * 129; i += GT) {
        const int g = i / (8 * 129), rem = i % (8 * 129), j = rem / 129, dl = rem % 129;
        const int r = (g == 0) ? 1 : (g == 1 ? 4 : 16), dist = dl * r; int bk;
        if (dist < 16) bk = dist; else { const int v = 16 + (int)(log((double)dist / 16.0) / log(128.0) * 16.0); bk = v < 31 ? v : 31; }
        bt[(g * 8 + j) * 132 + dl] = rel_bias[bk * 24 + g * 8 + j] * LOG2E;
    }
    f32x2v* lamb = (f32x2v*)(ws + TAB_LAMB); bf16* BB = (bf16*)(ws + TAB_BB); bf16* CM = (bf16*)(ws + TAB_CM);
    for (int i = gt; i < 2 * SSM_G * SSM_P; i += GT) {
        const int gi = i >> 6, p = i & 63;
        const double dt = exp((double)log_dt[gi]), lr = (double)lam_re[i], li = (double)lam_im[i];
        const double mag = exp(lr * dt), ang = li * dt, lbx = mag * cos(ang), lby = mag * sin(ang);
        const double nx = lbx - 1.0, ny = lby, den = lr * lr + li * li, qx = (nx * lr + ny * li) / den, qy = (ny * lr - nx * li) / den;
        lamb[i] = (f32x2v){(float)lbx, (float)lby};
        for (int c = 0; c < 16; ++c) { const double br = (double)b_re[(size_t)i * 16 + c], bi = (double)b_im[(size_t)i * 16 + c];
            BB[((size_t)gi * 128 + 2 * p) * 32 + c] = (bf16)f2bf((float)(qx * br - qy * bi)); BB[((size_t)gi * 128 + 2 * p + 1) * 32 + c] = (bf16)f2bf((float)(qx * bi + qy * br));
            BB[((size_t)gi * 128 + 2 * p) * 32 + 16 + c] = 0; BB[((size_t)gi * 128 + 2 * p + 1) * 32 + 16 + c] = 0; }
        for (int c = 0; c < 16; ++c) { CM[((size_t)gi * 16 + c) * 128 + 2 * p] = (bf16)f2bf(c_re[((size_t)gi * 16 + c) * 64 + p]); CM[((size_t)gi * 16 + c) * 128 + 2 * p + 1] = (bf16)f2bf(-c_im[((size_t)gi * 16 + c) * 64 + p]); }
    }
}
template <int MODE>
__device__ __forceinline__ void transpose_item(const float* W, int K, int ldw, int c0, int ncols, bf16* WT, int row0, LAS float* scr, int item, int lane, int ldk = 0, int kofs = 0, const float* gs = nullptr) {
    const int nblk = ncols / 32, kb = item / nblk, nb = item % nblk, k0 = 64 * kb, n0 = 32 * nb;
    float tv[32];
#pragma unroll
    for (int i = 0; i < 32; ++i) tv[i] = W[(size_t)(k0 + 2 * i + (lane >> 5)) * ldw + c0 + n0 + (lane & 31)];
    if (gs) {
#pragma unroll
        for (int i = 0; i < 32; ++i) tv[i] *= gs[k0 + 2 * i + (lane >> 5)]; }
#pragma unroll
    for (int i = 0; i < 32; ++i) scr[(2 * i + (lane >> 5)) * 33 + (lane & 31)] = tv[i];
    LDS_WAIT(); asm volatile("" ::: "memory");
    const int c = lane & 7;
#pragma unroll
    for (int j = 0; j < 4; ++j) { const int n = (lane >> 3) + 8 * j; const LAS float* s = scr + (8 * c) * 33 + n;
        v4u o; o.x = pk2(s[0 * 33], s[1 * 33]); o.y = pk2(s[2 * 33], s[3 * 33]); o.z = pk2(s[4 * 33], s[5 * 33]); o.w = pk2(s[6 * 33], s[7 * 33]);
        const int nn = n0 + n; const int drow = MODE ? row0 + (nn >> 7) * 256 + (nn & 127) : row0 + nn;
        *(GAS v4u*)(WT + (size_t)drow * (ldk ? ldk : K) + kofs + k0 + 8 * c) = o; }
    LDS_WAIT(); asm volatile("" ::: "memory");
}
template <int MODE>
__device__ __forceinline__ void transpose_item8(const float* W, int K, int ldw, int c0, int ncols, unsigned char* WT, int row0, LAS float* scr, int item, int lane, float scale, const float* gs = nullptr) {
    const int nblk = ncols / 32, kb = item / nblk, nb = item % nblk, k0 = 64 * kb, n0 = 32 * nb;
    float tv[32];
#pragma unroll
    for (int i = 0; i < 32; ++i) tv[i] = W[(size_t)(k0 + 2 * i + (lane >> 5)) * ldw + c0 + n0 + (lane & 31)];
    if (gs) {
#pragma unroll
        for (int i = 0; i < 32; ++i) tv[i] *= gs[k0 + 2 * i + (lane >> 5)]; }
#pragma unroll
    for (int i = 0; i < 32; ++i) scr[(2 * i + (lane >> 5)) * 33 + (lane & 31)] = tv[i] * scale;
    LDS_WAIT(); asm volatile("" ::: "memory");
    const int c = lane & 7;
    typedef unsigned u32x2v __attribute__((ext_vector_type(2)));
#pragma unroll
    for (int j = 0; j < 4; ++j) { const int n = (lane >> 3) + 8 * j; const LAS float* s = scr + (8 * c) * 33 + n;
        u32x2v o; o.x = pg8::pk4_fp8(s[0 * 33], s[1 * 33], s[2 * 33], s[3 * 33]); o.y = pg8::pk4_fp8(s[4 * 33], s[5 * 33], s[6 * 33], s[7 * 33]);
        const int nn = n0 + n; const int drow = MODE ? row0 + (nn >> 7) * 256 + (nn & 127) : row0 + nn;
        *(GAS u32x2v*)(WT + (size_t)drow * K + k0 + 8 * c) = o; }
    LDS_WAIT(); asm volatile("" ::: "memory");
}
__device__ __forceinline__ void convert_small_weights(const Ctx& C, const float* const* in, unsigned char* ws) {
    LAS float* scr = (LAS float*)(C.lds + C.wave * 16384);
    const int gw = C.vcu * NWAVES + C.wave, NGW = C.G * NWAVES;
    constexpr int I1 = 16 * 160, I2 = 16 * 64, I3 = 8 * 16, I4 = 8 * 32, I5 = 8 * 32, I6 = 16 * 32, IL = I1 + I2 + I3 + I4 + I5 + I6;
    constexpr int I7 = 16 * 88, I8 = 16 * 88, I9 = 44 * 32, NITEMS = 2 * IL + I7 + I8 + I9;
    for (int it = gw; it < NITEMS; it += NGW) {
        int r = it;
        if (r < 2 * IL) { const int l = r / IL; r -= l * IL; unsigned char* wl = ws + WS_WS + (size_t)l * WL_STRIDE;
#if QK_FP8
            if (r < I1) { constexpr int IQK = 16 * (NQK / 32);
                if (r < IQK) transpose_item8<0>(as_global(in[3]) + (size_t)l * DM * PW, DM, PW, 0, NQK, wl + WL_QKVU, 0, scr, r, C.lane, MOE_W13_SCALE, as_global(in[2]) + (size_t)l * DM);
                else transpose_item<0>(as_global(in[3]) + (size_t)l * DM * PW, DM, PW, NQK, NQKVU - NQK, (bf16*)(wl + WL_QKVU + WL_VU_OFF), 0, scr, r - IQK, C.lane, 0, 0, as_global(in[2]) + (size_t)l * DM);
                continue; } r -= I1;
#else
            if (r < I1) { transpose_item<0>(as_global(in[3]) + (size_t)l * DM * PW, DM, PW, 0, NQKVU, (bf16*)(wl + WL_QKVU), 0, scr, r, C.lane, 0, 0, as_global(in[2]) + (size_t)l * DM); continue; } r -= I1;
#endif
#if GATE_FP8
            if (r < I2) { transpose_item8<0>(as_global(in[3]) + (size_t)l * DM * PW, DM, PW, NQKVU, NGATE, wl + WL_G, 0, scr, r, C.lane, MOE_W13_SCALE, as_global(in[2]) + (size_t)l * DM); continue; } r -= I2;
#else
            if (r < I2) { transpose_item<0>(as_global(in[3]) + (size_t)l * DM * PW, DM, PW, NQKVU, NGATE, (bf16*)(wl + WL_G), 0, scr, r, C.lane, 0, 0, as_global(in[2]) + (size_t)l * DM); continue; } r -= I2;
#endif
            if (r < I3) { transpose_item<0>(as_global(in[12]) + (size_t)l * SW * SW, SW, SW, 0, SW, (bf16*)(wl + WL_GLU), 0, scr, r, C.lane); continue; } r -= I3;
            if (r < I4) { transpose_item<0>(as_global(in[14]) + (size_t)l * AOUT * DM, AOUT, DM, 0, DM, (bf16*)(wl + WL_ABR), 0, scr, r, C.lane, 2 * AOUT, 0); continue; } r -= I4;
            if (r < I5) { transpose_item<0>(as_global(in[15]) + (size_t)l * SW * DM, SW, DM, 0, DM, (bf16*)(wl + WL_ABR), 0, scr, r, C.lane, 2 * AOUT, AOUT); continue; } r -= I5;
            transpose_item<0>(as_global(in[16]) + (size_t)l * DM * DM, DM, DM, 0, DM, (bf16*)(wl + WL_OUT), 0, scr, r, C.lane); continue; }
        r -= 2 * IL;
        if (r < I7) { transpose_item<1>(as_global(in[18]), DM, FF, 0, FF, (bf16*)(ws + WS_W13), 0, scr, r, C.lane, 0, 0, as_global(in[17])); continue; } r -= I7;
        if (r < I8) { transpose_item<1>(as_global(in[19]), DM, FF, 0, FF, (bf16*)(ws + WS_W13), 128, scr, r, C.lane, 0, 0, as_global(in[17])); continue; } r -= I8;
        transpose_item<0>(as_global(in[20]), FF, DM, 0, DM, (bf16*)(ws + WS_W2), 0, scr, r, C.lane);
    }
}
__device__ __forceinline__ void convert_moe_weights(const Ctx& C, const float* const* in, unsigned char* ws, int nwc) {
    LAS float* scr = (LAS float*)(C.lds + C.wave * 16384);
    const int gw = C.vcu * nwc + C.wave, NGW = C.G * nwc;
    constexpr int IG = 16 * 112, ID = 56 * 32, IE = 2 * IG + ID, NITEMS = NEXP * IE;
    for (int it = gw; it < NITEMS; it += NGW) {
        const int e = it / IE; int r = it - e * IE;
        unsigned char* w13 = ws + WS_MW13 + (size_t)e * 2 * FFE * DM; unsigned char* w2 = ws + WS_MW2 + (size_t)e * DM * FFE;
        if (r < IG) { transpose_item8<1>(as_global(in[22]) + (size_t)e * DM * FFE, DM, FFE, 0, FFE, w13, 0, scr, r, C.lane, MOE_W13_SCALE); continue; } r -= IG;
        if (r < IG) { transpose_item8<1>(as_global(in[23]) + (size_t)e * DM * FFE, DM, FFE, 0, FFE, w13, 128, scr, r, C.lane, MOE_W13_SCALE); continue; } r -= IG;
        transpose_item8<0>(as_global(in[24]) + (size_t)e * FFE * DM, FFE, DM, 0, DM, w2, 0, scr, r, C.lane, MOE_W2_SCALE);
    }
}

__device__ __forceinline__ void prep_rows(const Ctx& C, const float* x, bf16* out, unsigned long long* ss, unsigned char* out8) {
    const int gw = C.vcu * NWAVES + C.wave, NGW = C.G * NWAVES;
    for (int m = gw; m < NTOK; m += 2 * NGW) {
        const int m2 = (m + NGW < NTOK) ? m + NGW : m;
        const GAS f32x4* xr = (const GAS f32x4*)(x + (size_t)m * DM) + C.lane; const GAS f32x4* xr2 = (const GAS f32x4*)(x + (size_t)m2 * DM) + C.lane;
        f32x4 v[4], w[4]; float s = 0.f, s2 = 0.f;
#pragma unroll
        for (int j = 0; j < 4; ++j) { v[j] = xr[64 * j]; w[j] = xr2[64 * j]; }
#pragma unroll
        for (int j = 0; j < 4; ++j) { s += (v[j].x * v[j].x + v[j].y * v[j].y) + (v[j].z * v[j].z + v[j].w * v[j].w); s2 += (w[j].x * w[j].x + w[j].y * w[j].y) + (w[j].z * w[j].z + w[j].w * w[j].w); }
        s = wave_sum(s); s2 = wave_sum(s2);
        GAS unsigned long long* o8 = (GAS unsigned long long*)(out + (size_t)m * DM) + C.lane; GAS unsigned long long* p8 = (GAS unsigned long long*)(out + (size_t)m2 * DM) + C.lane;
#pragma unroll
        for (int j = 0; j < 4; ++j) { o8[64 * j] = (unsigned long long)pk2(v[j].x, v[j].y) | ((unsigned long long)pk2(v[j].z, v[j].w) << 32); if (m2 != m) p8[64 * j] = (unsigned long long)pk2(w[j].x, w[j].y) | ((unsigned long long)pk2(w[j].z, w[j].w) << 32); }
        if (C.lane == 0) { ss[m] = (unsigned long long)(s * SS_SCALE); if (m2 != m) ss[m2] = (unsigned long long)(s2 * SS_SCALE); }
        if (out8) { GAS unsigned* q8 = (GAS unsigned*)(out8 + (size_t)m * DM) + C.lane; GAS unsigned* r8 = (GAS unsigned*)(out8 + (size_t)m2 * DM) + C.lane;
#pragma unroll
            for (int j = 0; j < 4; ++j) { q8[64 * j] = pg8::pk4_fp8(v[j].x * X8_SCALE, v[j].y * X8_SCALE, v[j].z * X8_SCALE, v[j].w * X8_SCALE);
                if (m2 != m) r8[64 * j] = pg8::pk4_fp8(w[j].x * X8_SCALE, w[j].y * X8_SCALE, w[j].z * X8_SCALE, w[j].w * X8_SCALE); } }
    }
}
__device__ __forceinline__ void attn_decode(int u, int& b, int& gj, int& rs, int& c, int& n) {
    const int bgj = u >> 7, blk = u & 127; b = bgj / 24; gj = bgj - b * 24; const int g = gj >> 3; rs = 2 * g; const int lg = 7 - rs;
    c = blk >> lg; n = blk & ((1 << lg) - 1);
}
__device__ __forceinline__ v4u f8x8_bf16(unsigned long long w, float inv) {
    const unsigned lo = (unsigned)w, hi = (unsigned)(w >> 32);
    const f32x2v a = __builtin_amdgcn_cvt_pk_f32_fp8(lo, false), b = __builtin_amdgcn_cvt_pk_f32_fp8(lo, true), c = __builtin_amdgcn_cvt_pk_f32_fp8(hi, false), d = __builtin_amdgcn_cvt_pk_f32_fp8(hi, true);
    return (v4u){cvtpk(a.x * inv, a.y * inv), cvtpk(b.x * inv, b.y * inv), cvtpk(c.x * inv, c.y * inv), cvtpk(d.x * inv, d.y * inv)};
}
__device__ __forceinline__ void attn_phase(const Ctx& C, const unsigned char* Qp, const unsigned char* Kp, const unsigned char* Vp, float* LSE, const float* biasg, bf16* Op) {
    LAS unsigned char* lds = C.lds;
    constexpr int KOFF = 0, VOFF = 32768, VROWS = 400, BOFF = VOFF + VROWS * 128;
    const int tid = C.tid, lane = C.lane, w = C.wave;
    for (int i = tid; i < 24 * 132; i += 512) ((LAS float*)(lds + BOFF))[i] = biasg[i];
    for (int i = tid; i < (BOFF - KOFF) / 16; i += 512) ((LAS v4u*)(lds + KOFF))[i] = (v4u){0u, 0u, 0u, 0u};
    const int u0 = (int)((long)C.vcu * 6144 / C.G), u1 = (int)((long)(C.vcu + 1) * 6144 / C.G);
    const int q15 = lane & 15, g4 = lane >> 4;
    const int srow = tid >> 3, sch = tid & 7;
    unsigned long long kreg[2], vreg[2], qn0, qn1;
    int b, gj, rs, c, n;
#define ATT_ISSUE(u_) do { attn_decode((u_), b, gj, rs, c, n); \
        _Pragma("unroll") for (int i = 0; i < 2; ++i) { const int tok = ((128 * n + srow + 64 * i) << rs) + c; \
            const size_t off = ((size_t)(b * SEQ + tok)) * AW + gj * 64 + sch * 8; kreg[i] = *(const GAS unsigned long long*)(Kp + off); vreg[i] = *(const GAS unsigned long long*)(Vp + off); } \
        { const unsigned char* qr_ = Qp + ((size_t)(b * SEQ + (((128 * n + 16 * w + q15) << rs) + c))) * AW + gj * 64; qn0 = *(const GAS unsigned long long*)(qr_ + 8 * g4); qn1 = *(const GAS unsigned long long*)(qr_ + 32 + 8 * g4); } } while (0)
    __syncthreads();
    if (u0 < u1) {
        attn_decode(u0, b, gj, rs, c, n);
        if (n > 0) {
#pragma unroll
            for (int i = 0; i < 2; ++i) { const int kr = srow + 64 * i, tok = ((128 * (n - 1) + kr) << rs) + c; const size_t off = ((size_t)(b * SEQ + tok)) * AW + gj * 64 + sch * 8;
                const v4u kv = f8x8_bf16(*(const GAS unsigned long long*)(Kp + off), 1.0f / QKV8_SKV), vv = f8x8_bf16(*(const GAS unsigned long long*)(Vp + off), 1.0f / QKV8_SKV); const int pr = ((n - 1) & 1) * 128 + kr;
                *(LAS v4u*)(lds + KOFF + pr * 128 + ((sch ^ ((pr >> 1) & 7)) << 4)) = kv;
                *(LAS v4u*)(lds + VOFF + pr * 128 + ((((sch >> 1) ^ ((pr >> 1) & 3)) << 5) | ((sch & 1) << 4))) = vv; }
        }
        ATT_ISSUE(u0);
    }
    const int klane0 = KOFF + q15 * 128 + (((0 + g4) ^ ((q15 >> 1) & 7)) << 4), klane1 = KOFF + q15 * 128 + (((4 + g4) ^ ((q15 >> 1) & 7)) << 4);
    const int vswz = (2 * g4 + (q15 >> 3)) & 3;
    int vlane[4];
#pragma unroll
    for (int db = 0; db < 4; ++db) vlane[db] = VOFF + (4 * g4 + (q15 >> 2)) * 128 + ((db ^ vswz) << 5) + (q15 & 3) * 8;
    float bq[9][4]; int gj_have = -1;
    for (int u = u0; u < u1; ++u) {
        __syncthreads();
        attn_decode(u, b, gj, rs, c, n);
        const int n_cur = n, gj_cur = gj;
#pragma unroll
        for (int i = 0; i < 2; ++i) { const int pr = (n_cur & 1) * 128 + srow + 64 * i;
            *(LAS v4u*)(lds + KOFF + pr * 128 + ((sch ^ ((pr >> 1) & 7)) << 4)) = f8x8_bf16(kreg[i], 1.0f / QKV8_SKV);
            *(LAS v4u*)(lds + VOFF + pr * 128 + ((((sch >> 1) ^ ((pr >> 1) & 3)) << 5) | ((sch & 1) << 4))) = f8x8_bf16(vreg[i], 1.0f / QKV8_SKV); }
        const int tokq = ((128 * n_cur + 16 * w + q15) << rs) + c;
        const size_t tokrow = (size_t)(b * SEQ + tokq);
        bf16* orow = Op + tokrow * AW + gj_cur * 64;
        const bf16x8 qf0 = __builtin_bit_cast(bf16x8, f8x8_bf16(qn0, 1.0f / QKV8_SQ)), qf1 = __builtin_bit_cast(bf16x8, f8x8_bf16(qn1, 1.0f / QKV8_SQ));
        if (gj_cur != gj_have) { const LAS float* bt = (const LAS float*)(lds + BOFF) + gj_cur * 132;
#pragma unroll
            for (int t = 0; t < 9; ++t)
#pragma unroll
                for (int r = 0; r < 4; ++r) { const int delta = 128 + q15 - (16 * t + 4 * g4 + r); bq[t][r] = bt[delta < 0 ? 0 : (delta > 128 ? 128 : delta)]; }
            gj_have = gj_cur; }
        __syncthreads();
        if (u + 1 < u1) ATT_ISSUE(u + 1);
        const int flip = ((n_cur & 1) ^ 1) << 7;
        bf16x8 kf[9][2];
#pragma unroll
        for (int t = 0; t < 9; ++t) { const int pb = ((16 * w + 16 * t) ^ flip) * 128; kf[t][0] = *(const LAS bf16x8*)(lds + klane0 + pb); kf[t][1] = *(const LAS bf16x8*)(lds + klane1 + pb); }
        f32x4 s[9];
#pragma unroll
        for (int t = 0; t < 9; ++t) {
            f32x4 a = (f32x4){0.f, 0.f, 0.f, 0.f};
            a = __builtin_amdgcn_mfma_f32_16x16x32_bf16(kf[t][0], qf0, a, 0, 0, 0);
            s[t] = __builtin_amdgcn_mfma_f32_16x16x32_bf16(kf[t][1], qf1, a, 0, 0, 0);
            asm volatile("" : "+v"(s[t]) : "v"(kf[t][0]), "v"(kf[t][1]));
        }
        asm volatile("s_nop 15\n\ts_nop 15" : "+v"(s[0]), "+v"(s[1]), "+v"(s[2]), "+v"(s[3]), "+v"(s[4]), "+v"(s[5]), "+v"(s[6]), "+v"(s[7]), "+v"(s[8]));
        float mx = -1e30f;
#pragma unroll
        for (int t = 0; t < 9; ++t)
#pragma unroll
            for (int r = 0; r < 4; ++r) { const int kvl = 16 * t + 4 * g4 + r, delta = 128 + q15 - kvl;
                bool valid = true; if (t == 0) valid = delta <= 128; if (t == 8) valid = delta >= 0;
                float v = s[t][r] + bq[t][r]; v = valid ? v : -1e30f; s[t][r] = v; }
        if (n_cur == 0) {
#pragma unroll
            for (int t = 0; t < 8; ++t)
#pragma unroll
                for (int r = 0; r < 4; ++r) if (16 * w + 16 * t + 4 * g4 + r < 128) s[t][r] = -1e30f;
        }
#pragma unroll
        for (int t = 0; t < 9; ++t) mx = fmaxf(fmaxf(mx, fmaxf(s[t][0], s[t][1])), fmaxf(s[t][2], s[t][3]));
        mx = fmaxf(mx, __shfl_xor(mx, 16)); mx = fmaxf(mx, __shfl_xor(mx, 32));
        float sum = 0.f;
#pragma unroll
        for (int t = 0; t < 9; ++t)
#pragma unroll
            for (int r = 0; r < 4; ++r) { const float p = __builtin_amdgcn_exp2f(s[t][r] - mx); s[t][r] = p; sum += p; }
        sum += __shfl_xor(sum, 16); sum += __shfl_xor(sum, 32);
        f32x4 o[4];
#pragma unroll
        for (int db = 0; db < 4; ++db) o[db] = (f32x4){0.f, 0.f, 0.f, 0.f};
#pragma unroll
        for (int s5 = 0; s5 < 5; ++s5) {
            v4u pw; pw.x = cvtpk(s[2 * s5][0], s[2 * s5][1]); pw.y = cvtpk(s[2 * s5][2], s[2 * s5][3]);
            if (s5 < 4) { pw.z = cvtpk(s[2 * s5 + 1][0], s[2 * s5 + 1][1]); pw.w = cvtpk(s[2 * s5 + 1][2], s[2 * s5 + 1][3]); } else { pw.z = 0u; pw.w = 0u; }
            const bf16x8 pf = __builtin_bit_cast(bf16x8, pw);
            const int x0 = 16 * w + 32 * s5, x1 = x0 + 16;
            const int p0 = (x0 ^ flip) * 128, p1 = (x1 ^ flip) * 128;
            v4i16_t lo[4], hi[4];
#pragma unroll
            for (int db = 0; db < 4; ++db) { lo[db] = __builtin_amdgcn_ds_read_tr16_b64_v4i16((LAS v4i16_t*)(lds + vlane[db] + p0)); hi[db] = __builtin_amdgcn_ds_read_tr16_b64_v4i16((LAS v4i16_t*)(lds + vlane[db] + p1)); }
#pragma unroll
            for (int db = 0; db < 4; ++db) {
                const bf16x8 vf = (bf16x8){lo[db][0], lo[db][1], lo[db][2], lo[db][3], hi[db][0], hi[db][1], hi[db][2], hi[db][3]};
                o[db] = __builtin_amdgcn_mfma_f32_16x16x32_bf16(vf, pf, o[db], 0, 0, 0);
                asm volatile("" : "+v"(o[db]) : "v"(vf), "v"(pf));
            }
        }
        asm volatile("s_nop 15\n\ts_nop 15" : "+v"(o[0]), "+v"(o[1]), "+v"(o[2]), "+v"(o[3]));
        const float inv = 1.0f / sum;
#pragma unroll
        for (int db = 0; db < 4; ++db) { const unsigned long long wv = (unsigned long long)pk2(o[db][0] * inv, o[db][1] * inv) | ((unsigned long long)pk2(o[db][2] * inv, o[db][3] * inv) << 32);
            *(GAS unsigned long long*)(orow + 16 * db + 4 * g4) = wv; }
        if (g4 == 0) LSE[tokrow * 24 + gj_cur] = mx + log2f(sum);
    }
#undef ATT_ISSUE
    __syncthreads();
}
__device__ __forceinline__ void attn_combine(const Ctx& C, const bf16* Qp, const float* LSE, bf16* AO) {
    const int gw = C.vcu * NWAVES + C.wave, NGW = C.G * NWAVES, lane = C.lane, j = lane >> 3;
    for (int m0 = gw; m0 < NTOK; m0 += 2 * NGW) {
        const int m1 = (m0 + NGW < NTOK) ? m0 + NGW : m0;
        float l[2][3]; v4u q[2][3];
#pragma unroll
        for (int r = 0; r < 2; ++r) { const int m = r ? m1 : m0; const GAS float* lp = (const GAS float*)LSE + (size_t)m * 24 + j; l[r][0] = lp[0]; l[r][1] = lp[8]; l[r][2] = lp[16];
            const bf16* qr = Qp + (size_t)m * AW + 8 * lane; q[r][0] = *(const GAS v4u*)qr; q[r][1] = *(const GAS v4u*)(qr + 512); q[r][2] = *(const GAS v4u*)(qr + 1024); }
#pragma unroll
        for (int r = 0; r < 2; ++r) { const int m = r ? m1 : m0;
            const float mx = fmaxf(l[r][0], fmaxf(l[r][1], l[r][2])); float w0 = __builtin_amdgcn_exp2f(l[r][0] - mx), w1 = __builtin_amdgcn_exp2f(l[r][1] - mx), w2 = __builtin_amdgcn_exp2f(l[r][2] - mx);
            const float inv = 1.0f / (w0 + w1 + w2); w0 *= inv; w1 *= inv; w2 *= inv;
            v4u o;
#pragma unroll
            for (int k = 0; k < 4; ++k) { const float lo = w0 * pg8::bflo(q[r][0][k]) + w1 * pg8::bflo(q[r][1][k]) + w2 * pg8::bflo(q[r][2][k]), hi = w0 * pg8::bfhi(q[r][0][k]) + w1 * pg8::bfhi(q[r][1][k]) + w2 * pg8::bfhi(q[r][2][k]); o[k] = pk2(lo, hi); }
            if (r == 0 || m1 != m0) *(GAS v4u*)(AO + (size_t)m * (2 * AOUT) + 8 * lane) = o; }
    }
}

template <bool PASS2>
__device__ __forceinline__ void ssm_pass(const Ctx& C, int layer, const bf16* U, bf16* Z, f32x2v* E, const unsigned char* ws, const float* dskip) {
    LAS unsigned char* wl = C.lds + C.wave * 12800; LAS float* BU = (LAS float*)wl; LAS unsigned char* XS = wl + 8448;
    const int lane = C.lane, p = lane, r16 = lane & 15, kg = lane >> 4;
    const int gwv = C.vcu * NWAVES + C.wave, NGW = C.G * NWAVES;
    constexpr int RUN = 4, NRUN = BATCH * SSM_G * NCHUNK / RUN;
    for (int rn = gwv; rn < NRUN; rn += NGW) {
        const int bg = rn / (NCHUNK / RUN), k0 = (rn % (NCHUNK / RUN)) * RUN, b = bg >> 5, g = bg & 31, gi = layer * SSM_G + g;
        const f32x2v lam = ((const GAS f32x2v*)(ws + TAB_LAMB))[gi * 64 + p];
        bf16x8 bfr[8];
#pragma unroll
        for (int nt = 0; nt < 8; ++nt) bfr[nt] = *(const GAS bf16x8*)((const bf16*)(ws + TAB_BB) + ((size_t)(gi * 128 + 16 * nt + r16)) * 32 + 8 * kg);
        bf16x8 cfr[4], dfr; float dsk = 0.f;
        float xr = 0.f, xi = 0.f;
        if (PASS2) {
#pragma unroll
            for (int ks = 0; ks < 4; ++ks) cfr[ks] = *(const GAS bf16x8*)((const bf16*)(ws + TAB_CM) + ((size_t)(gi * 16 + r16)) * 128 + 32 * ks + 8 * kg);
            dsk = dskip[16 * g + r16];
            { const unsigned dbits = f2bf(dsk); v4u dw = (v4u){0u, 0u, 0u, 0u};
#pragma unroll
              for (int j = 0; j < 8; ++j) if (8 * kg + j == r16) dw[j >> 1] |= dbits << (16 * (j & 1));
              dfr = __builtin_bit_cast(bf16x8, dw); }
            float tr = lam.x, ti = lam.y;
#pragma unroll
            for (int q = 0; q < 7; ++q) { const float nr = tr * tr - ti * ti; ti = 2.f * tr * ti; tr = nr; }
            const GAS f32x2v* Eb = (const GAS f32x2v*)E + ((size_t)bg * NCHUNK) * 64 + p;
            for (int j = 0; j < k0; j += 4) {
                const f32x2v e0 = Eb[(size_t)(j + 0) * 64], e1 = Eb[(size_t)(j + 1) * 64], e2 = Eb[(size_t)(j + 2) * 64], e3 = Eb[(size_t)(j + 3) * 64];
                float nr;
                nr = tr * xr - ti * xi + e0.x; xi = tr * xi + ti * xr + e0.y; xr = nr;
                nr = tr * xr - ti * xi + e1.x; xi = tr * xi + ti * xr + e1.y; xr = nr;
                nr = tr * xr - ti * xi + e2.x; xi = tr * xi + ti * xr + e2.y; xr = nr;
                nr = tr * xr - ti * xi + e3.x; xi = tr * xi + ti * xr + e3.y; xr = nr;
            }
        }
        const bf16* urow = U + (size_t)(b * SEQ + k0 * CHUNK + r16) * SW + 16 * g + 8 * kg;
        for (int kk = 0; kk < RUN; ++kk) {
            const int k = k0 + kk;
            if (!PASS2) { xr = 0.f; xi = 0.f; }
            for (int sub = 0; sub < 8; ++sub) {
                const int tok0 = b * SEQ + k * CHUNK + sub * 16;
                const bf16x8 a = *(const GAS bf16x8*)(urow + (size_t)(kk * 8 + sub) * 16 * SW);
                f32x4 dd[8];
#pragma unroll
                for (int nt = 0; nt < 8; ++nt) dd[nt] = __builtin_amdgcn_mfma_f32_16x16x32_bf16(a, bfr[nt], (f32x4){0.f, 0.f, 0.f, 0.f}, 0, 0, 0);
                asm volatile("s_nop 15\n\ts_nop 15" : "+v"(dd[0]), "+v"(dd[1]), "+v"(dd[2]), "+v"(dd[3]), "+v"(dd[4]), "+v"(dd[5]), "+v"(dd[6]), "+v"(dd[7]) : "v"(a));
#pragma unroll
                for (int nt = 0; nt < 8; ++nt)
#pragma unroll
                    for (int r = 0; r < 4; ++r) BU[(4 * kg + r) * 132 + 16 * nt + r16] = dd[nt][r];
#pragma unroll
                for (int t = 0; t < 16; ++t) { const f32x2v bu = *(const LAS f32x2v*)(BU + t * 132 + 2 * p);
                    const float nr = lam.x * xr - lam.y * xi + bu.x; xi = lam.x * xi + lam.y * xr + bu.y; xr = nr;
                    if (PASS2) *(LAS unsigned*)(XS + t * 272 + 4 * p) = cvtpk(xr, xi); }
                if (PASS2) {
                    f32x4 y = (f32x4){0.f, 0.f, 0.f, 0.f};
#pragma unroll
                    for (int ks = 0; ks < 4; ++ks) { const bf16x8 afr = *(const LAS bf16x8*)(XS + r16 * 272 + 64 * ks + 16 * kg); y = __builtin_amdgcn_mfma_f32_16x16x32_bf16(afr, cfr[ks], y, 0, 0, 0); asm volatile("" : "+v"(y) : "v"(afr)); }
                    y = __builtin_amdgcn_mfma_f32_16x16x32_bf16(a, dfr, y, 0, 0, 0);
                    asm volatile("s_nop 15\n\ts_nop 15" : "+v"(y) : "v"(a));
#pragma unroll
                    for (int r = 0; r < 4; ++r) { const size_t idx = (size_t)(tok0 + 4 * kg + r) * SW + 16 * g + r16; const float yy = y[r];
                        const float z = yy * sigm_f(1.5957691216057308f * (yy + 0.044715f * yy * yy * yy)); Z[idx] = (bf16)f2bf(z); }
                }
            }
            if (!PASS2) ((GAS f32x2v*)E)[((size_t)bg * NCHUNK + k) * 64 + p] = (f32x2v){xr, xi};
        }
    }
}
typedef unsigned u32x2b __attribute__((ext_vector_type(2)));
__device__ __forceinline__ f32x4 bf4(u32x2b w) { return (f32x4){pg8::bflo(w.x), pg8::bfhi(w.x), pg8::bflo(w.y), pg8::bfhi(w.y)}; }
constexpr int XO_LD = 2 * DM;
constexpr int ROUTE_LDS = 12544;
__device__ __forceinline__ void route_pass1(const Ctx& C, const bf16* x, const float* g2, const float* wrouter, unsigned char* ws, int wave_lo) {
    const int TPW = NTOK / C.G, t0 = C.vcu * TPW, lane = C.lane;
    LAS int* te = (LAS int*)(C.lds + ROUTE_LDS); LAS f32x2v* tg = (LAS f32x2v*)(C.lds + ROUTE_LDS + 1024); LAS int* lcnt = (LAS int*)(C.lds + ROUTE_LDS + 3072);
    if (C.tid < 8) lcnt[C.tid] = 0;
    f32x4 gv[4];
#pragma unroll
    for (int j = 0; j < 4; ++j) gv[j] = ((const f32x4*)g2)[lane + 64 * j];
    if (C.wave >= wave_lo)
    for (int r = C.wave - wave_lo; r < TPW; r += NWAVES - wave_lo) {
        const GAS u32x2b* xr = (const GAS u32x2b*)(x + (size_t)(t0 + r) * XO_LD) + lane;
        f32x4 v[4]; float s = 0.f;
#pragma unroll
        for (int j = 0; j < 4; ++j) { v[j] = bf4(xr[64 * j]); s += (v[j].x * v[j].x + v[j].y * v[j].y) + (v[j].z * v[j].z + v[j].w * v[j].w); }
        const float rstd = 1.f / sqrtf(wave_sum(s) * (1.f / DM) + EPS);
        float lg[8];
#pragma unroll
        for (int e = 0; e < 8; ++e) lg[e] = 0.f;
#pragma unroll
        for (int j = 0; j < 4; ++j) { const f32x4 h = v[j] * rstd * gv[j];
#pragma unroll
            for (int i = 0; i < 4; ++i) { const GAS f32x4* wp = (const GAS f32x4*)(wrouter + (size_t)(4 * lane + 256 * j + i) * 8); const f32x4 wa = wp[0], wb = wp[1];
                lg[0] += h[i] * wa.x; lg[1] += h[i] * wa.y; lg[2] += h[i] * wa.z; lg[3] += h[i] * wa.w; lg[4] += h[i] * wb.x; lg[5] += h[i] * wb.y; lg[6] += h[i] * wb.z; lg[7] += h[i] * wb.w; } }
#pragma unroll
        for (int e = 0; e < 8; ++e) lg[e] = wave_sum(lg[e]);
        if (lane == 0) {
            int e0 = 0; float v0 = lg[0];
#pragma unroll
            for (int e = 1; e < 8; ++e) if (lg[e] > v0) { v0 = lg[e]; e0 = e; }
            int e1 = -1; float v1 = -3.0e38f;
#pragma unroll
            for (int e = 0; e < 8; ++e) if (e != e0 && lg[e] > v1) { v1 = lg[e]; e1 = e; }
            const float g0 = 1.0f / (1.0f + expf(v1 - v0));
            te[r] = e0 | (e1 << 8); tg[r] = (f32x2v){g0, 1.0f - g0};
        }
    }
    __syncthreads();
    if (C.tid == 0) { for (int t = 0; t < TPW; ++t) { const int e = te[t]; const int r0 = lcnt[e & 255]; lcnt[e & 255] = r0 + 1; const int r1 = lcnt[e >> 8]; lcnt[e >> 8] = r1 + 1; const int tok = t0 + t;
        ((int*)(ws + TOK_E))[tok] = e; ((i32x2v*)(ws + TOK_R))[tok] = (i32x2v){r0, r1}; ((f32x2v*)(ws + TOK_G))[tok] = tg[t]; } }
    __syncthreads();
    if (C.tid < 8) ((int*)(ws + CNTWG))[C.vcu * 8 + C.tid] = lcnt[C.tid];
}
__device__ __forceinline__ int router_lds(int p) { return (p >> 8) * 16384 + 8448 + (p & 255) * 16; }
__device__ __forceinline__ void stage_router(const Ctx& C, const float* wrouter) {
    for (int q = C.tid; q < 2048; q += NWAVES * 64) { const int ln = q & 63, g = q >> 6, h = g & 1, i = (g >> 1) & 3, j = g >> 3;
        *(LAS f32x4*)(C.lds + router_lds(q)) = *(const GAS f32x4*)(wrouter + (size_t)(4 * ln + 256 * j + i) * 8 + 4 * h); }
}
__device__ __forceinline__ void route_row(const Ctx& C, const f32x4 (&v)[4], const f32x4 (&gv)[4], int r, LAS int* te, LAS f32x2v* tg) {
    const int lane = C.lane; float s = 0.f;
#pragma unroll
    for (int j = 0; j < 4; ++j) s += (v[j].x * v[j].x + v[j].y * v[j].y) + (v[j].z * v[j].z + v[j].w * v[j].w);
    const float rstd = 1.f / sqrtf(wave_sum(s) * (1.f / DM) + EPS);
    float lg[8];
#pragma unroll
    for (int e = 0; e < 8; ++e) lg[e] = 0.f;
#pragma unroll
    for (int j = 0; j < 4; ++j) { const f32x4 h = v[j] * rstd * gv[j];
#pragma unroll
        for (int i = 0; i < 4; ++i) { const f32x4 wa = *(const LAS f32x4*)(C.lds + router_lds(((j * 4 + i) * 2 + 0) * 64) + lane * 16), wb = *(const LAS f32x4*)(C.lds + router_lds(((j * 4 + i) * 2 + 1) * 64) + lane * 16);
            lg[0] += h[i] * wa.x; lg[1] += h[i] * wa.y; lg[2] += h[i] * wa.z; lg[3] += h[i] * wa.w; lg[4] += h[i] * wb.x; lg[5] += h[i] * wb.y; lg[6] += h[i] * wb.z; lg[7] += h[i] * wb.w; } }
#pragma unroll
    for (int e = 0; e < 8; ++e) lg[e] = wave_sum(lg[e]);
    if (lane == 0) {
        int e0 = 0; float v0 = lg[0];
#pragma unroll
        for (int e = 1; e < 8; ++e) if (lg[e] > v0) { v0 = lg[e]; e0 = e; }
        int e1 = -1; float v1 = -3.0e38f;
#pragma unroll
        for (int e = 0; e < 8; ++e) if (e != e0 && lg[e] > v1) { v1 = lg[e]; e1 = e; }
        const float g0 = 1.0f / (1.0f + expf(v1 - v0));
        te[r] = e0 | (e1 << 8); tg[r] = (f32x2v){g0, 1.0f - g0};
    }
}
__device__ __forceinline__ void r1_fused(const Ctx& C, const float* const* in, const bf16* x, const float* g2, const float* wrouter, unsigned char* ws) {
    const int TPW = NTOK / C.G, t0 = C.vcu * TPW, lane = C.lane;
    LAS int* te = (LAS int*)(C.lds + ROUTE_LDS); LAS f32x2v* tg = (LAS f32x2v*)(C.lds + ROUTE_LDS + 1024); LAS int* lcnt = (LAS int*)(C.lds + ROUTE_LDS + 3072);
    if (C.tid < 8) lcnt[C.tid] = 0;
    stage_router(C, wrouter);
    f32x4 gv[4];
#pragma unroll
    for (int j = 0; j < 4; ++j) gv[j] = ((const f32x4*)g2)[lane + 64 * j];
    __syncthreads();
    LAS float* scr = (LAS float*)(C.lds + C.wave * 16384);
    const int gw = C.vcu * NWAVES + C.wave, NGW = C.G * NWAVES;
    constexpr int IG = 16 * 112, ID = 56 * 32, IE = 2 * IG + ID, NITEMS = NEXP * IE;
    int rrow = C.wave;
    for (int it = gw; it < NITEMS; it += NGW) {
        const bool has_row = rrow < TPW;
        u32x2b xw[4];
        if (has_row) { const GAS u32x2b* xr = (const GAS u32x2b*)(x + (size_t)(t0 + rrow) * XO_LD) + lane;
#pragma unroll
            for (int j = 0; j < 4; ++j) xw[j] = xr[64 * j]; }
        const int e = it / IE; int r = it - e * IE;
        const float* W; unsigned char* WT; int K, ldw, ncols, row0, mode; float scale;
        if (r < 2 * IG) { const int up = r >= IG; r -= up * IG; W = as_global(in[22 + up]) + (size_t)e * DM * FFE; K = DM; ldw = FFE; ncols = FFE; WT = ws + WS_MW13 + (size_t)e * 2 * FFE * DM; row0 = 128 * up; mode = 1; scale = MOE_W13_SCALE; }
        else { r -= 2 * IG; W = as_global(in[24]) + (size_t)e * FFE * DM; K = FFE; ldw = DM; ncols = DM; WT = ws + WS_MW2 + (size_t)e * DM * FFE; row0 = 0; mode = 0; scale = MOE_W2_SCALE; }
        const int nblk = ncols / 32, kb = r / nblk, nb = r % nblk, k0 = 64 * kb, n0 = 32 * nb;
        float tv[32];
#pragma unroll
        for (int i = 0; i < 32; ++i) tv[i] = W[(size_t)(k0 + 2 * i + (lane >> 5)) * ldw + n0 + (lane & 31)];
        if (has_row) { f32x4 v[4];
#pragma unroll
            for (int j = 0; j < 4; ++j) v[j] = bf4(xw[j]);
            route_row(C, v, gv, rrow, te, tg); }
        rrow += NWAVES;
#pragma unroll
        for (int i = 0; i < 32; ++i) scr[(2 * i + (lane >> 5)) * 33 + (lane & 31)] = tv[i] * scale;
        LDS_WAIT(); asm volatile("" ::: "memory");
        const int c = lane & 7;
#pragma unroll
        for (int j = 0; j < 4; ++j) { const int n = (lane >> 3) + 8 * j; const LAS float* s = scr + (8 * c) * 33 + n;
            u32x2b o; o.x = pg8::pk4_fp8(s[0 * 33], s[1 * 33], s[2 * 33], s[3 * 33]); o.y = pg8::pk4_fp8(s[4 * 33], s[5 * 33], s[6 * 33], s[7 * 33]);
            const int nn = n0 + n; const int drow = mode ? row0 + (nn >> 7) * 256 + (nn & 127) : row0 + nn;
            *(GAS u32x2b*)(WT + (size_t)drow * K + k0 + 8 * c) = o; }
        LDS_WAIT(); asm volatile("" ::: "memory");
    }
    for (; rrow < TPW; rrow += NWAVES) {
        const GAS u32x2b* xr = (const GAS u32x2b*)(x + (size_t)(t0 + rrow) * XO_LD) + lane; f32x4 v[4];
#pragma unroll
        for (int j = 0; j < 4; ++j) v[j] = bf4(xr[64 * j]);
        route_row(C, v, gv, rrow, te, tg); }
    __syncthreads();
    if (C.tid == 0) { for (int t = 0; t < TPW; ++t) { const int e = te[t]; const int r0 = lcnt[e & 255]; lcnt[e & 255] = r0 + 1; const int r1 = lcnt[e >> 8]; lcnt[e >> 8] = r1 + 1; const int tok = t0 + t;
        ((int*)(ws + TOK_E))[tok] = e; ((i32x2v*)(ws + TOK_R))[tok] = (i32x2v){r0, r1}; ((f32x2v*)(ws + TOK_G))[tok] = tg[t]; } }
    __syncthreads();
    if (C.tid < 8) ((int*)(ws + CNTWG))[C.vcu * 8 + C.tid] = lcnt[C.tid];
}
__device__ __forceinline__ void moe_bases(const Ctx& C, const unsigned char* ws) {
    LAS int* ctl = (LAS int*)(C.lds + LDSCTL_OFF);
    LAS int* lc = (LAS int*)(C.lds + 32768);
    __syncthreads();
    for (int i = C.tid; i < C.G * 8; i += NWAVES * 64) lc[i] = __hip_atomic_load((const int*)(ws + CNTWG) + i, __ATOMIC_RELAXED, __HIP_MEMORY_SCOPE_AGENT);
    __syncthreads();
    { const int e = C.wave; int tot = 0, mine = 0;
        for (int w = C.lane; w < C.G; w += 64) { const int cv = lc[w * 8 + e]; tot += cv; if (w < C.vcu) mine += cv; }
#pragma unroll
        for (int o = 1; o < 64; o <<= 1) { tot += __shfl_xor(tot, o); mine += __shfl_xor(mine, o); }
        if (C.lane == 0) { ctl[32 + e] = tot; ctl[40 + e] = mine; } }
    __syncthreads();
    if (C.tid == 0) { int tb = 0; for (int e = 0; e < 8; ++e) { ctl[e] = tb; ctl[16 + e] = tb * 256 + ctl[40 + e]; tb += (ctl[32 + e] + 255) >> 8; } ctl[8] = tb; }
    __syncthreads();
}
__device__ __forceinline__ void route_pass2(const Ctx& C, const bf16* x, const float* g2, unsigned char* ws) {
    const int TPW = NTOK / C.G, t0 = C.vcu * TPW, lane = C.lane;
    LAS int* ctl = (LAS int*)(C.lds + LDSCTL_OFF); LAS i32x2v* sl = (LAS i32x2v*)(C.lds + ROUTE_LDS);
    moe_bases(C, ws);
    if (C.tid < TPW) { const int tok = t0 + C.tid; const int e = ((const int*)(ws + TOK_E))[tok]; const i32x2v r = ((const i32x2v*)(ws + TOK_R))[tok];
        const i32x2v s = (i32x2v){ctl[16 + (e & 255)] + r.x, ctl[16 + (e >> 8)] + r.y}; ((i32x2v*)(ws + TOK_S))[tok] = s; sl[C.tid] = s; }
    __syncthreads();
    f32x4 gv[4];
#pragma unroll
    for (int j = 0; j < 4; ++j) gv[j] = ((const f32x4*)g2)[lane + 64 * j];
    unsigned char* XS = ws + WS_XS;
    for (int r = C.wave; r < TPW; r += 2 * NWAVES) {
        const int r2 = r + NWAVES;
        const GAS u32x2b* xr = (const GAS u32x2b*)(x + (size_t)(t0 + r) * XO_LD) + lane; const GAS u32x2b* xq = (const GAS u32x2b*)(x + (size_t)(t0 + r2) * XO_LD) + lane;
        f32x4 v[4], w[4]; float s = 0.f, s2 = 0.f;
#pragma unroll
        for (int j = 0; j < 4; ++j) { v[j] = bf4(xr[64 * j]); w[j] = bf4(xq[64 * j]); }
#pragma unroll
        for (int j = 0; j < 4; ++j) { s += (v[j].x * v[j].x + v[j].y * v[j].y) + (v[j].z * v[j].z + v[j].w * v[j].w); s2 += (w[j].x * w[j].x + w[j].y * w[j].y) + (w[j].z * w[j].z + w[j].w * w[j].w); }
        const float rstd = 1.f / sqrtf(wave_sum(s) * (1.f / DM) + EPS), rstd2 = 1.f / sqrtf(wave_sum(s2) * (1.f / DM) + EPS);
        const i32x2v st = sl[r], st2 = sl[r2];
        GAS unsigned* o0 = (GAS unsigned*)(XS + (size_t)st.x * DM) + lane; GAS unsigned* o1 = (GAS unsigned*)(XS + (size_t)st.y * DM) + lane;
        GAS unsigned* p0 = (GAS unsigned*)(XS + (size_t)st2.x * DM) + lane; GAS unsigned* p1 = (GAS unsigned*)(XS + (size_t)st2.y * DM) + lane;
#pragma unroll
        for (int j = 0; j < 4; ++j) { const f32x4 h = v[j] * rstd * gv[j]; const unsigned wv = pg8::pk4_fp8(h.x, h.y, h.z, h.w); o0[64 * j] = wv; o1[64 * j] = wv;
            const f32x4 h2 = w[j] * rstd2 * gv[j]; const unsigned wv2 = pg8::pk4_fp8(h2.x, h2.y, h2.z, h2.w); p0[64 * j] = wv2; p1[64 * j] = wv2; }
    }
}
__device__ __forceinline__ void final_rows(const Ctx& C, const bf16* xb, float* x, const float* fg, const unsigned char* ws) {
    const int gw = C.vcu * NWAVES + C.wave, NGW = C.G * NWAVES, lane = C.lane;
    f32x4 gv[4];
#pragma unroll
    for (int j = 0; j < 4; ++j) gv[j] = ((const GAS f32x4*)fg)[lane + 64 * j];
    const bf16* XS = (const bf16*)(ws + WS_Y);
    for (int m0 = gw; m0 < NTOK; m0 += 2 * NGW) {
        const int m1 = (m0 + NGW < NTOK) ? m0 + NGW : m0;
        const i32x2v sa = ((const GAS i32x2v*)(ws + TOK_S))[m0], sb = ((const GAS i32x2v*)(ws + TOK_S))[m1]; const f32x2v ga = ((const GAS f32x2v*)(ws + TOK_G))[m0], gb = ((const GAS f32x2v*)(ws + TOK_G))[m1];
        f32x4 v[2][4]; unsigned long long ya[2][4], yb[2][4];
#pragma unroll
        for (int r = 0; r < 2; ++r) { const int m = r ? m1 : m0; const i32x2v st = r ? sb : sa;
            const GAS u32x2b* xr = (const GAS u32x2b*)(xb + (size_t)m * XO_LD) + lane;
            const GAS unsigned long long* y0 = (const GAS unsigned long long*)(XS + (size_t)st.x * DM) + lane; const GAS unsigned long long* y1 = (const GAS unsigned long long*)(XS + (size_t)st.y * DM) + lane;
#pragma unroll
            for (int j = 0; j < 4; ++j) { v[r][j] = bf4(xr[64 * j]); ya[r][j] = y0[64 * j]; yb[r][j] = y1[64 * j]; } }
#pragma unroll
        for (int r = 0; r < 2; ++r) { const int m = r ? m1 : m0; const f32x2v gt = r ? gb : ga; float s = 0.f;
#pragma unroll
            for (int j = 0; j < 4; ++j) { const unsigned a0 = (unsigned)ya[r][j], a1 = (unsigned)(ya[r][j] >> 32), b0 = (unsigned)yb[r][j], b1 = (unsigned)(yb[r][j] >> 32);
                v[r][j].x += gt.x * pg8::bflo(a0) + gt.y * pg8::bflo(b0); v[r][j].y += gt.x * pg8::bfhi(a0) + gt.y * pg8::bfhi(b0);
                v[r][j].z += gt.x * pg8::bflo(a1) + gt.y * pg8::bflo(b1); v[r][j].w += gt.x * pg8::bfhi(a1) + gt.y * pg8::bfhi(b1);
                s += (v[r][j].x * v[r][j].x + v[r][j].y * v[r][j].y) + (v[r][j].z * v[r][j].z + v[r][j].w * v[r][j].w); }
            const float rstd = 1.f / sqrtf(wave_sum(s) * (1.f / DM) + EPS);
            if (r == 0 || m1 != m0) { GAS f32x4* xw = (GAS f32x4*)(x + (size_t)m * DM) + lane;
#pragma unroll
                for (int j = 0; j < 4; ++j) xw[64 * j] = v[r][j] * rstd * gv[j]; } }
    }
}
struct MoeOrder {
    pg8::StaticOrder so; int t0; int tb1, tb2, tb3, tb4, tb5, tb6, tb7; size_t estride;
    __device__ __forceinline__ bool next(int i, pg8::Unit& u) const {
        if (!so.next(i, u)) return false;
        u.pm += t0; const int e = (u.pm >= tb1) + (u.pm >= tb2) + (u.pm >= tb3) + (u.pm >= tb4) + (u.pm >= tb5) + (u.pm >= tb6) + (u.pm >= tb7);
        u.boff = (size_t)e * estride; return true;
    }
    __device__ __forceinline__ void a_ready(const pg8::Unit&) const {}
    __device__ __forceinline__ void done(const pg8::Unit&) const {}
};
#ifndef DBG_SSM2
#define DBG_SSM2 0
#endif
#ifndef DBG_ATT2
#define DBG_ATT2 0
#endif
#ifndef MK_SPLIT
#define MK_SPLIT 0
#endif
#ifndef DBG_SUM_BYTES
#define DBG_SUM_BYTES 0
#define DBG_SUM_OFF 8
#define DBG_SUM_MASK 0xffffffffu
#endif
#ifndef DBG_AX
#define DBG_AX 0
#define DBG_AX_N 0
#define DBG_AX_LIVE_G 77
#define DBG_AX_LIVE 1
#endif
#ifndef GEMM_SP2
#define GEMM_SP2 true
#endif
struct ProbeOrder { pg8::StaticOrder so; int mode;
    __device__ __forceinline__ bool next(int i, pg8::Unit& u) const { if (!so.next(i, u)) return false; if (mode == 2) { u.pm = 0; u.pn = 0; } else if (mode == 3) u.pn = 0; else if (mode == 4) u.pm = 0; return true; }
    __device__ __forceinline__ void a_ready(const pg8::Unit&) const {}
    __device__ __forceinline__ void done(const pg8::Unit&) const {}
};
struct Args { const float* in[26]; float* out; unsigned char* ws; int l, p; };
#if MK_SPLIT
#define RUN_PHASE_INLINE __forceinline__
#else
#define RUN_PHASE_INLINE __noinline__
#endif
__device__ __forceinline__ void make_ctx(Ctx& C, unsigned char* lds_raw) { int t_ = threadIdx.x; asm volatile("" : "+v"(t_));
    C.lds = (LAS unsigned char*)lds_raw; C.tid = t_; C.lane = t_ & 63; C.wave = __builtin_amdgcn_readfirstlane(t_ >> 6);
    C.G = gridDim.x; { const int bx = blockIdx.x; C.vcu = (C.G % 8 == 0) ? (bx % 8) * (C.G / 8) + bx / 8 : bx; } }
enum { PH_P0 = 0, PH_A, PH_B, PH_C, PH_D, PH_E, PH_F, PH_N2, PH_FUP, PH_FDN, PH_N1, PH_R1, PH_R2, PH_MOE, PH_FIN, PH_COUNT };
template <int PH> __device__ __forceinline__ void run_phase(unsigned char* lds_raw, const float* const* in, float* out, unsigned char* ws, int l, int p) {
    ws = as_global(ws); out = as_global(out);
    Ctx C; make_ctx(C, lds_raw);
    LAS unsigned char* ring = C.lds;
    unsigned char* wl = ws + WS_WS + (size_t)l * WL_STRIDE;
    bf16* Hb = (bf16*)(ws + WS_H); bf16* QP = (bf16*)(ws + WS_QP); bf16* KP = (bf16*)(ws + WS_KP); bf16* VP = (bf16*)(ws + WS_VP);
    bf16* Ub = (bf16*)(ws + WS_U); bf16* Zb = (bf16*)(ws + WS_Z); bf16* AOb = (bf16*)(ws + WS_AO); bf16* Gb = (bf16*)(ws + WS_G); bf16* Mb = (bf16*)(ws + WS_M); bf16* ZGb = (bf16*)(ws + WS_ZG);
    float* LSE = (float*)(ws + WS_LSE); f32x2v* Eb = (f32x2v*)(ws + WS_E);
    if constexpr (PH == PH_P0) {
        build_tables(C, as_global(in[1]), as_global(in[4]), as_global(in[5]), as_global(in[6]), as_global(in[7]), as_global(in[8]), as_global(in[9]), as_global(in[10]), ws);
        convert_small_weights(C, in, ws);
        prep_rows(C, as_global(in[0]), Hb, (unsigned long long*)(ws + SS_P0), GATE_FP8 ? (unsigned char*)out : nullptr);
    } else if constexpr (PH == PH_A) {
#if QK_FP8
        {
            pg8::Gemm g{(const bf16*)out, (const bf16*)(wl + WL_QKVU), NTOK, NQK, DM / 2, E8_W13, E8_X}; pg8::StaticOrder S; S.init(NTOK, NQK, C.G, (int)blockIdx.x);
            pg8::EpiProj E{(bf16*)(ws + WS_VP), (bf16*)(ws + WS_KP), (bf16*)(ws + WS_KP + 48 * MiB), Ub, 0.125f * LOG2E, (const unsigned long long*)(ws + (l == 0 ? SS_P0 : SS_B)), 0, QKV8_SQ, QKV8_SKV};
            pg8::gemm_phase<pg8::EpiProj, pg8::StaticOrder, true, true, true>(ring, g, S, E); }
        __syncthreads();
        {
            pg8::Gemm g{Hb, (const bf16*)(wl + WL_QKVU + WL_VU_OFF), NTOK, NQKVU - NQK, DM}; pg8::StaticOrder S; S.init(NTOK, NQKVU - NQK, C.G, (int)blockIdx.x);
            pg8::EpiProj E{(bf16*)(ws + WS_VP), (bf16*)(ws + WS_KP), (bf16*)(ws + WS_KP + 48 * MiB), Ub, 0.125f * LOG2E, (const unsigned long long*)(ws + (l == 0 ? SS_P0 : SS_B)), NQK / 256, QKV8_SQ, QKV8_SKV};
            pg8::gemm_phase<pg8::EpiProj, pg8::StaticOrder, true, GEMM_SP2>(ring, g, S, E); }
#else
        pg8::Gemm g{Hb, (const bf16*)(wl + WL_QKVU), NTOK, NQKVU, DM}; pg8::StaticOrder S; S.init(NTOK, NQKVU, C.G, (int)blockIdx.x);
        pg8::EpiProj E{(bf16*)(ws + WS_VP), (bf16*)(ws + WS_KP), (bf16*)(ws + WS_KP + 48 * MiB), Ub, 0.125f * LOG2E, (const unsigned long long*)(ws + (l == 0 ? SS_P0 : SS_B)), 0, QKV8_SQ, QKV8_SKV};
        pg8::gemm_phase<pg8::EpiProj, pg8::StaticOrder, true, GEMM_SP2>(ring, g, S, E);
#endif
    } else if constexpr (PH == PH_B) {
        attn_phase(C, ws + WS_VP, ws + WS_KP, ws + WS_KP + 48 * MiB, LSE, (const float*)(ws + TAB_BIAS), QP);
        ssm_pass<false>(C, l, Ub, nullptr, Eb, ws, nullptr);
        if (DBG_SSM2) ssm_pass<false>(C, l, Ub, nullptr, Eb, ws, nullptr);
    } else if constexpr (PH == PH_C) {
        ssm_pass<true>(C, l, Ub, Zb, Eb, ws, as_global(in[11]) + (size_t)l * SW);
        if (DBG_SSM2) ssm_pass<true>(C, l, Ub, Zb, Eb, ws, as_global(in[11]) + (size_t)l * SW);
        if (DBG_SSM2 == 2) attn_combine(C, QP, LSE, AOb);
        attn_combine(C, QP, LSE, AOb);
        __syncthreads();
        pg8::StaticOrder S; S.init(NTOK, NGATE, C.G, (int)blockIdx.x);
        pg8::EpiSig E{Gb, NGATE, (const unsigned long long*)(ws + (l == 0 ? SS_P0 : SS_B))};
#if GATE_FP8
        pg8::Gemm g{(const bf16*)out, (const bf16*)(wl + WL_G), NTOK, NGATE, DM / 2, E8_W13, E8_X};
        pg8::gemm_phase<pg8::EpiSig, pg8::StaticOrder, true, true, true>(ring, g, S, E);
#else
        pg8::Gemm g{Hb, (const bf16*)(wl + WL_G), NTOK, NGATE, DM};
        pg8::gemm_phase<pg8::EpiSig, pg8::StaticOrder, true, GEMM_SP2>(ring, g, S, E);
#endif
    } else if constexpr (PH == PH_D) {
        pg8::Gemm g{Zb, (const bf16*)(wl + WL_GLU), NTOK, SW, SW}; pg8::StaticOrder S; S.init(NTOK, SW, C.G, (int)blockIdx.x);
        pg8::EpiGlu E{Zb, AOb + AOUT, SW, 2 * AOUT, as_global(in[13]) + (size_t)l * SW};
        pg8::gemm_phase<pg8::EpiGlu, pg8::StaticOrder, true, GEMM_SP2>(ring, g, S, E);
    } else if constexpr (PH == PH_E) {
        pg8::Gemm g{AOb, (const bf16*)(wl + WL_ABR), NTOK, DM, 2 * AOUT}; pg8::StaticOrder S; S.init(NTOK, DM, C.G, (int)blockIdx.x);
        pg8::EpiGateMid E{Gb, NGATE, DM, Mb, DM};
        pg8::gemm_phase<pg8::EpiGateMid, pg8::StaticOrder, true, GEMM_SP2>(ring, g, S, E);
    } else if constexpr (PH == PH_F) {
        pg8::Gemm g{Mb, (const bf16*)(wl + WL_OUT), NTOK, DM, DM}; pg8::StaticOrder S; S.init(NTOK, DM, C.G, (int)blockIdx.x);
        if (l == 0) { pg8::EpiResidB<true> E{Hb, DM, Hb, DM, (unsigned long long*)(ws + SS_A), nullptr};
            pg8::gemm_phase<pg8::EpiResidB<true>, pg8::StaticOrder, true, GEMM_SP2>(ring, g, S, E); }
        else { pg8::EpiResidB<false> E{Hb, DM, (bf16*)out, XO_LD, nullptr, nullptr};
            pg8::gemm_phase<pg8::EpiResidB<false>, pg8::StaticOrder, true, GEMM_SP2>(ring, g, S, E); }
    } else if constexpr (PH == PH_N2) {
    } else if constexpr (PH == PH_FUP) {
        pg8::Gemm g{Hb, (const bf16*)(ws + WS_W13), NTOK, 2 * FF, DM}; pg8::StaticOrder S; S.init(NTOK, 2 * FF, C.G, (int)blockIdx.x);
        pg8::EpiSwiGlu E{(bf16*)(ws + WS_HID), FF, (const unsigned long long*)(ws + SS_A)};
        pg8::gemm_phase<pg8::EpiSwiGlu, pg8::StaticOrder, true, GEMM_SP2>(ring, g, S, E);
    } else if constexpr (PH == PH_FDN) {
        pg8::Gemm g{(const bf16*)(ws + WS_HID), (const bf16*)(ws + WS_W2), NTOK, DM, FF}; pg8::StaticOrder S; S.init(NTOK, DM, C.G, (int)blockIdx.x);
        pg8::EpiResidB<true> E{Hb, DM, Hb, DM, (unsigned long long*)(ws + SS_B), GATE_FP8 ? (unsigned char*)out : nullptr};
        pg8::gemm_phase<pg8::EpiResidB<true>, pg8::StaticOrder, true, GEMM_SP2>(ring, g, S, E);
    } else if constexpr (PH == PH_N1) {
    } else if constexpr (PH == PH_R1) {
        r1_fused(C, in, (const bf16*)out, as_global(in[17]) + DM, as_global(in[21]), ws);
    } else if constexpr (PH == PH_R2) {
#ifndef DBG_MB
#define DBG_MB 0
#endif
        for (int rr = 0; rr < DBG_MB; ++rr) moe_bases(C, ws);
        route_pass2(C, (const bf16*)out, as_global(in[17]) + DM, ws);
    } else if constexpr (PH == PH_MOE) {
        moe_bases(C, ws);
        const LAS int* tbl = (const LAS int*)(C.lds + LDSCTL_OFF);
        const int tb1 = __builtin_amdgcn_readfirstlane(tbl[1]), tb2 = __builtin_amdgcn_readfirstlane(tbl[2]), tb3 = __builtin_amdgcn_readfirstlane(tbl[3]), tb4 = __builtin_amdgcn_readfirstlane(tbl[4]),
                  tb5 = __builtin_amdgcn_readfirstlane(tbl[5]), tb6 = __builtin_amdgcn_readfirstlane(tbl[6]), tb7 = __builtin_amdgcn_readfirstlane(tbl[7]), nT = __builtin_amdgcn_readfirstlane(tbl[8]);
        if (p >= 1) {
            pg8::Gemm g{(const bf16*)(ws + WS_HID0), (const bf16*)(ws + WS_MW2), nT * 256, DM, FFE / 2, E8_W2, E8_HID};
            MoeOrder S; S.so.init(nT * 256, DM, C.G, (int)blockIdx.x); S.t0 = 0; S.tb1 = tb1; S.tb2 = tb2; S.tb3 = tb3; S.tb4 = tb4; S.tb5 = tb5; S.tb6 = tb6; S.tb7 = tb7; S.estride = (size_t)DM * FFE;
            pg8::EpiPlain E{(bf16*)(ws + WS_Y), DM};
            pg8::gemm_phase<pg8::EpiPlain, MoeOrder, true, true, true>(ring, g, S, E);
        } else {
            pg8::Gemm g{(const bf16*)(ws + WS_XS), (const bf16*)(ws + WS_MW13), nT * 256, 2 * FFE, DM / 2, E8_W13, E8_ONE};
            MoeOrder S; S.so.init(nT * 256, 2 * FFE, C.G, (int)blockIdx.x); S.t0 = 0; S.tb1 = tb1; S.tb2 = tb2; S.tb3 = tb3; S.tb4 = tb4; S.tb5 = tb5; S.tb6 = tb6; S.tb7 = tb7; S.estride = (size_t)2 * FFE * DM;
            pg8::EpiSwiGlu8 E{ws + WS_HID0, FFE, MOE_HID_SCALE, MOE_HID_MAX};
            pg8::gemm_phase<pg8::EpiSwiGlu8, MoeOrder, true, true, true>(ring, g, S, E);
        }
    } else if constexpr (PH == PH_FIN) {
        final_rows(C, (const bf16*)out, out, as_global(in[25]), ws);
    }
}
template <int PH> __global__ void __launch_bounds__(NWAVES * 64, 2) phase_kernel(Args args) {
    extern __shared__ __attribute__((aligned(16))) unsigned char lds_raw[];
    for (int u = threadIdx.x; u < (LDS_BYTES - LDSCTL_OFF) / 4; u += NWAVES * 64) ((LAS unsigned*)((LAS unsigned char*)lds_raw + LDSCTL_OFF))[u] = 0u;
    __syncthreads();
    run_phase<PH>(lds_raw, args.in, args.out, args.ws, args.l, args.p);
}
#ifndef DBG_TIME
#define DBG_TIME 0
#define DBG_T1 1
#define DBG_T1N 1
#define DBG_T2 2
#define DBG_T2N 1
#endif
#ifndef DBG_CP
#define DBG_CP 0
#endif
#define CHECKPOINT(id) do { if (DBG_CP == (id)) { \
        const unsigned* src_ = (DBG_SUM_OFF == 9999) ? (const unsigned*)out : (const unsigned*)(ws + (size_t)DBG_SUM_OFF * MiB); unsigned acc_ = 0u; \
        for (size_t i = (size_t)blockIdx.x * 512 + threadIdx.x; i < (size_t)DBG_SUM_BYTES / 4; i += (size_t)gridDim.x * 512) acc_ += (src_[i] & DBG_SUM_MASK) * (unsigned)(2654435761u + 2u * (unsigned)(i & 1023u)); \
        _Pragma("unroll") for (int o = 1; o < 64; o <<= 1) acc_ += __shfl_xor(acc_, o); \
        if ((threadIdx.x & 63) == 0) atomicAdd((unsigned*)(ctl + 16), acc_); \
        xcd_barrier(bar); \
        const unsigned tot_ = __hip_atomic_load((unsigned*)(ctl + 16), __ATOMIC_RELAXED, __HIP_MEMORY_SCOPE_AGENT); \
        xcd_barrier(bar); \
        for (size_t i = (size_t)blockIdx.x * 512 + threadIdx.x; i < (size_t)NTOK * DM; i += (size_t)gridDim.x * 512) out[i] = (float)((tot_ >> (i & 15)) & 0xffu) * (1.0f / 256.0f) + 0.25f; \
        return; } } while (0)
__global__ void __launch_bounds__(NWAVES * 64, 2) mega_fwd(Args args) {
    extern __shared__ __attribute__((aligned(16))) unsigned char lds_raw[];
    for (int u = threadIdx.x; u < (LDS_BYTES - LDSCTL_OFF) / 4; u += NWAVES * 64) ((LAS unsigned*)((LAS unsigned char*)lds_raw + LDSCTL_OFF))[u] = 0u;
    __syncthreads();
    unsigned char* ws = args.ws;
    gu32* ctl = (gu32*)(ws + WS_CTL);
    volatile LAS unsigned* MISC = (volatile LAS unsigned*)((LAS unsigned char*)lds_raw + MISC_OFF);
    const XcdBarrier bar = xcd_barrier_post((unsigned*)(ctl + CW_BAR), MISC + 8);
    const float* const* in = args.in; float* out = args.out;
#ifndef DBG_REP_PH
#define DBG_REP_PH -1
#define DBG_REP_L 0
#define DBG_REP_P 0
#define DBG_REP_N 0
#endif
#define PHASE(PH, l_, p_) do { constexpr int nrep_ = ((PH) == DBG_REP_PH && (l_) == DBG_REP_L && (p_) == DBG_REP_P) ? 1 + DBG_REP_N : 1; \
        for (int rep_ = 0; rep_ < nrep_; ++rep_) { run_phase<PH>(lds_raw, in, out, ws, (l_), (p_)); if (rep_ + 1 < nrep_) xcd_barrier(bar); } } while (0)
#if DBG_TIME
#define SEAM do { xcd_barrier(bar); if (blockIdx.x == 0 && threadIdx.x == 0) { ((unsigned long long*)(ctl + 2048))[seam_i] = __builtin_amdgcn_s_memrealtime(); } ++seam_i; } while (0)
    int seam_i = 1;
    if (blockIdx.x == 0 && threadIdx.x == 0) ((unsigned long long*)(ctl + 2048))[0] = __builtin_amdgcn_s_memrealtime();
#else
#define SEAM xcd_barrier(bar)
#endif
    PHASE(PH_P0, 0, 0); SEAM;
    PHASE(PH_A, 0, 0); SEAM; CHECKPOINT(1); PHASE(PH_B, 0, 0); SEAM; CHECKPOINT(2);

    PHASE(PH_C, 0, 0); SEAM; CHECKPOINT(3); PHASE(PH_D, 0, 0); SEAM; CHECKPOINT(4); PHASE(PH_E, 0, 0); SEAM; CHECKPOINT(5); PHASE(PH_F, 0, 0); SEAM; CHECKPOINT(6);
    PHASE(PH_FUP, 0, 0); SEAM; CHECKPOINT(8); PHASE(PH_FDN, 0, 0); SEAM; CHECKPOINT(9);
    PHASE(PH_A, 1, 0); SEAM; PHASE(PH_B, 1, 0); SEAM; PHASE(PH_C, 1, 0); SEAM; PHASE(PH_D, 1, 0); SEAM; PHASE(PH_E, 1, 0); SEAM; PHASE(PH_F, 1, 0); SEAM;
    PHASE(PH_R1, 1, 0); SEAM; PHASE(PH_R2, 1, 0); SEAM;
    PHASE(PH_MOE, 1, 0); SEAM; PHASE(PH_MOE, 1, 1); SEAM;
    PHASE(PH_FIN, 1, 0);
#if DBG_TIME
    SEAM; SEAM;
    {
        const unsigned long long* T = (const unsigned long long*)(ctl + 2048);
        const unsigned long long a0 = __hip_atomic_load(T + DBG_T1 - 1, __ATOMIC_RELAXED, __HIP_MEMORY_SCOPE_AGENT), a1 = __hip_atomic_load(T + DBG_T1 + DBG_T1N - 1, __ATOMIC_RELAXED, __HIP_MEMORY_SCOPE_AGENT);
        const unsigned long long b0 = __hip_atomic_load(T + DBG_T2 - 1, __ATOMIC_RELAXED, __HIP_MEMORY_SCOPE_AGENT), b1 = __hip_atomic_load(T + DBG_T2 + DBG_T2N - 1, __ATOMIC_RELAXED, __HIP_MEMORY_SCOPE_AGENT);
        const float t1 = (float)(a1 - a0) * 0.01f, t2 = (float)(b1 - b0) * 0.01f; const float cval = sqrtf(t1 * 0.1f);
        for (size_t i = (size_t)blockIdx.x * 512 + threadIdx.x; i < (size_t)NTOK * DM; i += (size_t)gridDim.x * 512) out[i] = (i == 0) ? (t2 + 100.0f) : cval;
    }
#endif
#undef PHASE
#undef SEAM
}

template <int PH> static void launch_phase(const Args& a, int l, int p, int grid, hipStream_t stream) {
    static bool attr_set = false;
    if (!attr_set) { (void)hipFuncSetAttribute((const void*)phase_kernel<PH>, hipFuncAttributeMaxDynamicSharedMemorySize, LDS_BYTES); attr_set = true; }
    Args b = a; b.l = l; b.p = p;
    hipLaunchKernelGGL(phase_kernel<PH>, dim3(grid), dim3(NWAVES * 64), LDS_BYTES, stream, b);
}
extern "C" void kernel_launch(void* const* d_in, const int* in_sizes, int n_in, void* d_out, int out_size, void* d_ws, size_t ws_size, hipStream_t stream) {
    static int grid = 0;
    if (grid == 0) {
        if (n_in != 26 || in_sizes[0] != NTOK * DM || out_size != NTOK * DM || ws_size < WS_END) { fprintf(stderr, "kernel_launch: unexpected shapes (n_in %d, in0 %d, out %d, ws %zu); nothing launched\n", n_in, n_in > 0 ? in_sizes[0] : -1, out_size, ws_size); grid = -1; return; }
        int dev = 0, cus = 0, per_cu = 0;
        if (hipGetDevice(&dev) != hipSuccess || hipDeviceGetAttribute(&cus, hipDeviceAttributeMultiprocessorCount, dev) != hipSuccess) { grid = -1; return; }
        if (hipFuncSetAttribute((const void*)mega_fwd, hipFuncAttributeMaxDynamicSharedMemorySize, LDS_BYTES) != hipSuccess) { fprintf(stderr, "kernel_launch: hipFuncSetAttribute failed\n"); grid = -1; return; }
        if (hipOccupancyMaxActiveBlocksPerMultiprocessor(&per_cu, (const void*)mega_fwd, NWAVES * 64, LDS_BYTES) != hipSuccess || per_cu < 1)
            fprintf(stderr, "kernel_launch: note: occupancy query reports %d workgroups per CU\n", per_cu);
        (void)hipGetLastError();
        grid = cus;
        if (grid != 256) { fprintf(stderr, "kernel_launch: %d CUs; this kernel is laid out for 256\n", cus); grid = 256; }
    }
    if (grid < 0) return;
    if (hipMemsetAsync((char*)d_ws + WS_CTL, 0, CTL_ZERO_BYTES, stream) != hipSuccess) return;
    Args a{};
    for (int i = 0; i < 26; ++i) a.in[i] = (const float*)d_in[i];
    a.out = (float*)d_out; a.ws = (unsigned char*)d_ws; a.l = 0; a.p = 0;
#if MK_SPLIT
    launch_phase<PH_P0>(a, 0, 0, grid, stream);
    for (int l = 0; l < 2; ++l) {
        launch_phase<PH_A>(a, l, 0, grid, stream); launch_phase<PH_B>(a, l, 0, grid, stream); launch_phase<PH_C>(a, l, 0, grid, stream);
        launch_phase<PH_D>(a, l, 0, grid, stream); launch_phase<PH_E>(a, l, 0, grid, stream); launch_phase<PH_F>(a, l, 0, grid, stream);
        if (l == 0) { launch_phase<PH_FUP>(a, 0, 0, grid, stream); launch_phase<PH_FDN>(a, 0, 0, grid, stream); }
        else { launch_phase<PH_R1>(a, 1, 0, grid, stream); launch_phase<PH_R2>(a, 1, 0, grid, stream);
            for (int p = 0; p <= MOE_NCHUNK; ++p) launch_phase<PH_MOE>(a, 1, p, grid, stream);
            launch_phase<PH_FIN>(a, 1, 0, grid, stream); }
    }
#else
    hipLaunchKernelGGL(mega_fwd, dim3(grid), dim3(NWAVES * 64), LDS_BYTES, stream, a);
#endif
    const hipError_t le = hipPeekAtLastError();
    if (le != hipSuccess) fprintf(stderr, "kernel_launch: launch failed: %s\n", hipGetErrorName(le));
}
```
